# Optimizing an MI355X kernel written in HIP

```python
import jax, jax.numpy as jnp
from jax import lax
import numpy as np

D_MODEL = 1024
BATCH = 8
SEQ = 2048
DEPTH = 2

MIX_WIDTH = D_MODEL
SGU_WIDTH = MIX_WIDTH // 2
SGU_GROUPS = 4
SGU_GROUP_DIM = SGU_WIDTH // SGU_GROUPS
CHUNK = 128
SB_WIDTH = MIX_WIDTH - SGU_WIDTH
SB_HEADS = 8
SB_HEAD_DIM = SB_WIDTH // SB_HEADS
Q_BLOCK = 128
IN_COLS = 2 * SGU_WIDTH + 3 * SB_WIDTH
MEM_LEN = 256
MEM_HEADS = 4
MEM_HEAD_DIM = D_MODEL // MEM_HEADS
N_EXPERTS = 32
TOP_K = 4
D_EXPERT = D_MODEL
SWIGLU_LIMIT = 7.0
SWIGLU_ALPHA = 1.702
MOE_BLOCK = 128
DEEPNORM_ALPHA = (2 * DEPTH) ** 0.25
DEEPNORM_BETA = (8 * DEPTH) ** -0.25
LN_EPS = 1e-5
RMS_EPS = 1e-6

kernel_name = 'hybrid_sgu_stickbreak_mem_moe_deepnorm'


def layer_norm(x, g, b):
    xf = x.astype(jnp.float32)
    mu = jnp.mean(xf, axis=-1, keepdims=True)
    var = jnp.mean(jnp.square(xf - mu), axis=-1, keepdims=True)
    y = (xf - mu) * lax.rsqrt(var + LN_EPS)
    return (y * g.astype(jnp.float32) + b.astype(jnp.float32)).astype(x.dtype)


def group_layer_norm(x, g, b, groups):
    shp = x.shape
    xf = x.astype(jnp.float32).reshape(shp[:-1] + (groups, shp[-1] // groups))
    mu = jnp.mean(xf, axis=-1, keepdims=True)
    var = jnp.mean(jnp.square(xf - mu), axis=-1, keepdims=True)
    y = ((xf - mu) * lax.rsqrt(var + LN_EPS)).reshape(shp)
    return (y * g.astype(jnp.float32) + b.astype(jnp.float32)).astype(x.dtype)


def group_rms(x, groups):
    shp = x.shape
    xf = x.astype(jnp.float32).reshape(shp[:-1] + (groups, shp[-1] // groups))
    y = xf * lax.rsqrt(jnp.mean(jnp.square(xf), axis=-1, keepdims=True) + RMS_EPS)
    return y.reshape(shp).astype(x.dtype)


def stick_breaking_attention(q, k, v):
    S = q.shape[2]
    scale = SB_HEAD_DIM ** -0.5
    qf = q.astype(jnp.float32)
    kf = k.astype(jnp.float32)
    outs = []
    for i in range(S // Q_BLOCK):
        lo, hi = i * Q_BLOCK, (i + 1) * Q_BLOCK
        z = jnp.einsum('bhtd,bhsd->bhts', qf[:, :, lo:hi], kf[:, :, :hi]) * scale
        t_pos = lo + jnp.arange(Q_BLOCK)[:, None]
        s_pos = jnp.arange(hi)[None, :]
        mask = s_pos < t_pos
        log_not = jnp.where(mask, jax.nn.log_sigmoid(-z), 0.0)
        log_w = jax.nn.log_sigmoid(z) + lax.cumsum(log_not, axis=3, reverse=True) - log_not
        a = jnp.where(mask, jnp.exp(log_w), 0.0)
        outs.append(jnp.einsum('bhts,bhsd->bhtd', a.astype(v.dtype), v[:, :, :hi]))
    return jnp.concatenate(outs, axis=2)


def parallel_mixer(h, w_in, sgu_g, sgu_b, w_sp, b_sp, grp_g, w_out):
    B, S, _ = h.shape
    proj = h @ w_in
    u, v_s, q, k, v = jnp.split(
        proj, [SGU_WIDTH, 2 * SGU_WIDTH, 2 * SGU_WIDTH + SB_WIDTH, 2 * SGU_WIDTH + 2 * SB_WIDTH], axis=-1)
    u = jax.nn.gelu(u)
    v_s = group_layer_norm(jax.nn.gelu(v_s), sgu_g, sgu_b, SGU_GROUPS)
    vc = v_s.reshape(B, S // CHUNK, CHUNK, SGU_GROUPS, SGU_GROUP_DIM)
    causal = jnp.tril(jnp.ones((CHUNK, CHUNK), dtype=bool))
    w_c = jnp.where(causal[None], w_sp, 0.0).astype(vc.dtype)
    sg = jnp.einsum('gts,bcsgd->bctgd', w_c, vc) + b_sp.T[:, :, None]
    out_a = u * sg.reshape(B, S, SGU_WIDTH)
    to_heads = lambda t: t.reshape(B, S, SB_HEADS, SB_HEAD_DIM).transpose(0, 2, 1, 3)
    out_b = stick_breaking_attention(to_heads(q), to_heads(k), to_heads(v))
    out_b = out_b.transpose(0, 2, 1, 3).reshape(B, S, SB_WIDTH)
    y = jnp.concatenate([group_rms(out_a, SGU_GROUPS), group_rms(out_b, SB_HEADS)], axis=-1) * grp_g
    return y @ w_out


def memory_attention(x, mem, wq, wkv, wo):
    B, S, D = x.shape
    M = mem.shape[1]
    q = (x @ wq).reshape(B, S, MEM_HEADS, MEM_HEAD_DIM)
    k, v = jnp.split(mem @ wkv, 2, axis=-1)
    k = k.reshape(B, M, MEM_HEADS, MEM_HEAD_DIM)
    v = v.reshape(B, M, MEM_HEADS, MEM_HEAD_DIM)
    s = jnp.einsum('bshd,bmhd->bhsm', q.astype(jnp.float32), k.astype(jnp.float32)) * (MEM_HEAD_DIM ** -0.5)
    p = jax.nn.softmax(s, axis=-1).astype(x.dtype)
    o = jnp.einsum('bhsm,bmhd->bshd', p, v).reshape(B, S, D)
    return o @ wo


def moe(x, w_router, b_router, w_gu, b_gu, w_down, b_down):
    B, S, D = x.shape
    N = B * S
    NK = N * TOP_K
    x2 = x.reshape(N, D)
    logits = (x2 @ w_router + b_router).astype(jnp.float32)
    top_val, top_idx = lax.top_k(logits, TOP_K)
    gates = jax.nn.softmax(top_val, axis=-1).astype(x.dtype)
    flat_e = top_idx.reshape(NK).astype(jnp.int32)
    flat_tok = jnp.arange(NK, dtype=jnp.int32) // TOP_K
    order = jnp.argsort(flat_e)
    e_sorted = flat_e[order]
    tok_sorted = flat_tok[order]
    gate_sorted = gates.reshape(NK)[order]
    counts = jnp.bincount(flat_e, length=N_EXPERTS)
    starts = jnp.cumsum(counts) - counts
    padded = ((counts + MOE_BLOCK - 1) // MOE_BLOCK) * MOE_BLOCK
    pend = jnp.cumsum(padded)
    pstart = pend - padded
    dest = pstart[e_sorted] + jnp.arange(NK, dtype=jnp.int32) - starts[e_sorted]
    P = ((NK + MOE_BLOCK - 1) // MOE_BLOCK) * MOE_BLOCK + N_EXPERTS * MOE_BLOCK
    n_blocks = P // MOE_BLOCK
    row_tok = jnp.full((P,), N, dtype=jnp.int32).at[dest].set(tok_sorted)
    x_pad = jnp.concatenate([x2, jnp.zeros((1, D), x2.dtype)], axis=0)
    rows = x_pad[row_tok].reshape(n_blocks, MOE_BLOCK, D)
    block_e = jnp.searchsorted(pend, jnp.arange(n_blocks) * MOE_BLOCK, side='right')
    block_e = jnp.clip(block_e, 0, N_EXPERTS - 1)

    def expert_block(args):
        xb, e = args
        hgu = xb @ w_gu[e] + b_gu[e]
        g, u = hgu[:, :D_EXPERT], hgu[:, D_EXPERT:]
        g = jnp.minimum(g, SWIGLU_LIMIT)
        u = jnp.clip(u, -SWIGLU_LIMIT, SWIGLU_LIMIT)
        a = (u + 1.0) * (g * jax.nn.sigmoid(SWIGLU_ALPHA * g))
        return a @ w_down[e] + b_down[e]

    y = lax.map(expert_block, (rows, block_e)).reshape(P, D)
    y_sel = y[dest] * gate_sorted[:, None]
    out = jax.ops.segment_sum(y_sel, tok_sorted, num_segments=N)
    return out.reshape(B, S, D)


def setup_inputs(seed: int = 0) -> dict:
    key = jax.random.key(seed)
    ks = jax.random.split(key, 24)
    f32 = jnp.float32
    nrm = lambda k, shp, s: jax.random.normal(k, shp, f32) * s
    L, D, E, F = DEPTH, D_MODEL, N_EXPERTS, D_EXPERT
    return {
        'x': nrm(ks[0], (BATCH, SEQ, D), 1.0),
        'mem': nrm(ks[1], (BATCH, MEM_LEN, D), 1.0),
        'w_in': nrm(ks[2], (L, D, IN_COLS), D ** -0.5),
        'sgu_g': 1.0 + nrm(ks[3], (L, SGU_WIDTH), 0.1),
        'sgu_b': nrm(ks[4], (L, SGU_WIDTH), 0.02),
        'w_sp': nrm(ks[5], (L, SGU_GROUPS, CHUNK, CHUNK), CHUNK ** -0.5),
        'b_sp': 1.0 + nrm(ks[6], (L, SGU_GROUPS, CHUNK), 0.1),
        'grp_g': 1.0 + nrm(ks[7], (L, MIX_WIDTH), 0.1),
        'w_out': nrm(ks[8], (L, MIX_WIDTH, D), DEEPNORM_BETA * MIX_WIDTH ** -0.5),
        'wq_mem': nrm(ks[9], (L, D, D), D ** -0.5),
        'wkv_mem': nrm(ks[10], (L, D, 2 * D), D ** -0.5),
        'wo_mem': nrm(ks[11], (L, D, D), DEEPNORM_BETA * D ** -0.5),
        'w_router': nrm(ks[12], (L, D, E), D ** -0.5),
        'b_router': nrm(ks[13], (L, E), 0.01),
        'w_gu': nrm(ks[14], (L, E, D, 2 * F), D ** -0.5),
        'b_gu': nrm(ks[15], (L, E, 2 * F), 0.02),
        'w_down': nrm(ks[16], (L, E, F, D), DEEPNORM_BETA * F ** -0.5),
        'b_down': nrm(ks[17], (L, E, D), 0.02),
        'ln_g': 1.0 + nrm(ks[18], (L, 3, D), 0.1),
        'ln_b': nrm(ks[19], (L, 3, D), 0.02),
    }


def reference(x, mem, w_in, sgu_g, sgu_b, w_sp, b_sp, grp_g, w_out, wq_mem, wkv_mem, wo_mem,
              w_router, b_router, w_gu, b_gu, w_down, b_down, ln_g, ln_b):
    for l in range(DEPTH):
        mix = parallel_mixer(x, w_in[l], sgu_g[l], sgu_b[l], w_sp[l], b_sp[l], grp_g[l], w_out[l])
        x = layer_norm(DEEPNORM_ALPHA * x + mix, ln_g[l, 0], ln_b[l, 0])
        xa = memory_attention(x, mem, wq_mem[l], wkv_mem[l], wo_mem[l])
        x = layer_norm(DEEPNORM_ALPHA * x + xa, ln_g[l, 1], ln_b[l, 1])
        ff = moe(x, w_router[l], b_router[l], w_gu[l], b_gu[l], w_down[l], b_down[l])
        x = layer_norm(DEEPNORM_ALPHA * x + ff, ln_g[l, 2], ln_b[l, 2])
    return x
```

```cpp
#include <hip/hip_runtime.h>
#include <cstdio>
#include <cstdint>

#define LAS __attribute__((address_space(3)))
typedef unsigned short bf16_t;
typedef short bf16x8 __attribute__((ext_vector_type(8)));
typedef short s16x4 __attribute__((ext_vector_type(4)));
typedef float f32x4 __attribute__((ext_vector_type(4)));
typedef float f32x2 __attribute__((ext_vector_type(2)));
typedef unsigned u32x4 __attribute__((ext_vector_type(4)));
typedef unsigned u32x2 __attribute__((ext_vector_type(2)));
typedef __bf16 bf16x2_t __attribute__((ext_vector_type(2)));

constexpr int NB = 8, SEQ = 2048, DM = 1024, NTOK = NB * SEQ, DEPTH = 2;
constexpr int INC = 2560;
constexpr int MEML = 256, MEMROWS = NB * MEML;
constexpr int NE = 32, TOPK = 4;
constexpr int PROWS = NTOK * TOPK + NE * 256;
constexpr float ALPHA = 1.4142135623730951f;
constexpr float LN_EPS = 1e-5f, RMS_EPS = 1e-6f;

constexpr size_t MiB = 1u << 20;
constexpr size_t WS_CTL = 0, CTL_BYTES = 1 * MiB;
constexpr size_t WS_XB = 1 * MiB;
constexpr size_t WS_MEMB = 33 * MiB;
constexpr size_t WS_PROJ = 37 * MiB;
constexpr size_t WS_KM = 117 * MiB;
constexpr size_t WS_VT = 121 * MiB;
constexpr size_t WS_YMIX = 125 * MiB;
constexpr size_t WS_SBUF = 157 * MiB;
constexpr size_t WS_X1 = 221 * MiB;
constexpr size_t WS_X1B = 285 * MiB;
constexpr size_t WS_QM = 317 * MiB;
constexpr size_t WS_OM = 349 * MiB;
constexpr size_t WS_X2 = 381 * MiB;
constexpr size_t WS_X2B = 445 * MiB;
constexpr size_t WS_ROUTE = 477 * MiB;
constexpr size_t ROUTE_LAYER = 5 * MiB;
constexpr size_t WS_ABUF = 487 * MiB;
constexpr size_t WS_YBUF = 631 * MiB;
constexpr size_t WS_X3 = 775 * MiB;
constexpr size_t WS_END = 839 * MiB;
constexpr int CW_BAR = 4096;
constexpr int CW_CNT = 8192;

constexpr int LDS_TAB = 131072;
constexpr int LDS_MISC = 131072 + 2048;
constexpr int LDS_BYTES = 147456;

__device__ __forceinline__ float bf2f(unsigned h) { return __uint_as_float(h << 16); }
__device__ __forceinline__ unsigned pk_bf16(float lo, float hi) { f32x2 v = {lo, hi}; bf16x2_t b = __builtin_convertvector(v, bf16x2_t); return __builtin_bit_cast(unsigned, b); }
__device__ __forceinline__ float fast_exp2(float x) { return __builtin_amdgcn_exp2f(x); }
__device__ __forceinline__ float fast_log2(float x) { return __builtin_amdgcn_logf(x); }
__device__ __forceinline__ float fast_rcp(float x) { return __builtin_amdgcn_rcpf(x); }
__device__ __forceinline__ float fast_rsq(float x) { return __builtin_amdgcn_rsqf(x); }
__device__ __forceinline__ float gelu_tanh(float x) {
    const float y = 1.5957691216057308f * x * (1.0f + 0.044715f * x * x);
    return x * fast_rcp(1.0f + fast_exp2(-1.4426950408889634f * y));
}
__device__ __forceinline__ float wave_sum(float v) {
#pragma unroll
    for (int o = 1; o < 64; o <<= 1) v += __shfl_xor(v, o);
    return v;
}
#define VM_WAIT() asm volatile("s_waitcnt vmcnt(0)" ::: "memory")
#define WG_BARRIER() do { asm volatile("s_waitcnt vmcnt(0) lgkmcnt(0)" ::: "memory"); __builtin_amdgcn_s_barrier(); asm volatile("" ::: "memory"); } while (0)

#define XB_TMO      128
#define XB_XCNT(j)  (256  + 64 * (j))
#define XB_XSUB(j)  (1280 + 64 * (j))
#define XB_XGEN(j)  (2304 + 64 * (j))
#define XB_TOP      3328
#define XB_TOPGEN   3392
#define XCD_BAR_WORDS 3456
#define XB_SPIN_CAP (1u << 20)
__device__ __forceinline__ unsigned xb_ld(unsigned* p)              { return __hip_atomic_load(p, __ATOMIC_RELAXED, __HIP_MEMORY_SCOPE_AGENT); }
__device__ __forceinline__ unsigned xb_add(unsigned* p, unsigned v) { return __hip_atomic_fetch_add(p, v, __ATOMIC_RELAXED, __HIP_MEMORY_SCOPE_AGENT); }
__device__ __forceinline__ unsigned xb_xcc_id() { return (unsigned)__builtin_amdgcn_s_getreg((3 << 11) | 20) & 0xFu; }
#define XB_SPIN(cond, bar) do { unsigned _sp = 0; while (cond) { __builtin_amdgcn_s_sleep(1); \
    if ((++_sp & 255u) == 0u) { if (xb_ld(&(bar)[XB_TMO])) break; if (_sp > XB_SPIN_CAP) { atomicAdd(&(bar)[XB_TMO], 1u); break; } } } } while (0)
struct XcdBarrier { unsigned* bar; unsigned x; volatile LAS unsigned* st; };
__device__ __forceinline__ XcdBarrier xcd_barrier_post(unsigned* bar, volatile LAS unsigned* st) {
    XcdBarrier b; b.bar = bar; b.x = xb_xcc_id(); b.st = st;
    if (threadIdx.x == 0) (void)xb_add(&bar[XB_XCNT(b.x)], 1u);
    return b;
}
__device__ __forceinline__ void xcd_barrier_complete(unsigned* bar, unsigned x, unsigned& nloc, unsigned& nx) {
    const unsigned G = gridDim.x * gridDim.y * gridDim.z;
    unsigned sum, cnt, mine, sp = 0u;
    for (;;) {
        sum = 0u; cnt = 0u; mine = 0u;
#pragma unroll
        for (unsigned j = 0; j < 16; ++j) { const unsigned c = xb_ld(&bar[XB_XCNT(j)]); sum += c; cnt += (c > 0u) ? 1u : 0u; mine = (j == x) ? c : mine; }
        if (sum == G) break;
        __builtin_amdgcn_s_sleep(1);
        if ((++sp & 255u) == 0u) { if (xb_ld(&bar[XB_TMO])) break; if (sp > XB_SPIN_CAP) { atomicAdd(&bar[XB_TMO], 1u); break; } }
    }
    nloc = mine > 0u ? mine : 1u; nx = cnt > 0u ? cnt : 1u;
}
__device__ __forceinline__ void xcd_barrier(const XcdBarrier& b) {
    asm volatile("s_waitcnt vmcnt(0)" ::: "memory");
    __syncthreads();
    if (threadIdx.x == 0) {
        unsigned* bar = b.bar;
        __builtin_amdgcn_s_waitcnt(0);
        unsigned nloc = b.st[0], nx = b.st[1];
        if (nloc == 0u) { xcd_barrier_complete(bar, b.x, nloc, nx); b.st[0] = nloc; b.st[1] = nx; }
        const unsigned old = xb_add(&bar[XB_XSUB(b.x)], 1u);
        const unsigned gen = old / nloc;
        if (old + 1u == (gen + 1u) * nloc) {
            __builtin_amdgcn_fence(__ATOMIC_RELEASE, "agent");
            asm volatile("s_waitcnt vmcnt(0)" ::: "memory");
            const unsigned og = xb_add(&bar[XB_TOP], 1u);
            const unsigned tg = og / nx;
            if (og + 1u == (tg + 1u) * nx) xb_add(&bar[XB_TOPGEN], 1u);
            else XB_SPIN(xb_ld(&bar[XB_TOPGEN]) == tg, bar);
            __builtin_amdgcn_fence(__ATOMIC_ACQUIRE, "agent");
            xb_add(&bar[XB_XGEN(b.x)], 1u);
            asm volatile("s_waitcnt vmcnt(0)" ::: "memory");
        } else {
            XB_SPIN(xb_ld(&bar[XB_XGEN(b.x)]) == gen, bar);
            __builtin_amdgcn_fence(__ATOMIC_ACQUIRE, "agent");
            asm volatile("s_waitcnt vmcnt(0)" ::: "memory");
        }
    }
    __syncthreads();
}

__device__ __forceinline__ int swz(int row) { return ((row >> 1) & 7) ^ ((row >> 4) & 1); }
constexpr int GK = 1024, GNT = GK / 64;
struct RowLinear { int row0; __device__ __forceinline__ int operator()(int r) const { return row0 + r; } };
struct RowList { const int* list; int n; __device__ __forceinline__ int operator()(int r) const { return r < n ? list[r] : 0; } };

template <class RowMap, class Epi>
__device__ __forceinline__ void gemm_tile(LAS unsigned char* lds, const bf16_t* A, const int lda, const RowMap& rm,
                                          const float* Bw, const int ldb, const int bc0, const int bc1, const Epi& epi) {
    int tid = threadIdx.x; asm volatile("" : "+v"(tid));
    const int lane = tid & 63, wid = __builtin_amdgcn_readfirstlane(tid >> 6);
    const int wr = wid >> 2, wc = wid & 3, fr = lane & 15, fq = lane >> 4;
    const char* ap[4];
#pragma unroll
    for (int p = 0; p < 4; ++p) { const int r = 32 * wid + 8 * p + (lane >> 3); const int gr = rm(r); const int lc = (lane & 7) ^ swz(r);
        ap[p] = (const char*)(A + (size_t)gr * lda) + lc * 16; }
    const float* bp = Bw + (size_t)(8 * wid) * ldb + ((lane >> 5) ? bc1 : bc0) + 4 * (lane & 31);
    unsigned bw[4];
#pragma unroll
    for (int c = 0; c < 4; ++c) { const int row = 32 * (lane >> 3) + 16 * (lane & 1) + 4 * ((lane & 7) >> 1) + c; bw[c] = 65536u + (unsigned)(row * 128 + ((wid ^ swz(row)) << 4)); }
    const int sw = (fr >> 1) & 7;
    f32x4 acc[2][2][4][2];
#pragma unroll
    for (int a = 0; a < 2; ++a)
#pragma unroll
        for (int b = 0; b < 2; ++b)
#pragma unroll
            for (int m = 0; m < 4; ++m)
#pragma unroll
                for (int n = 0; n < 2; ++n) acc[a][b][m][n] = (f32x4){0.f, 0.f, 0.f, 0.f};
    f32x4 breg[8];
    unsigned aro = (unsigned)((64 * wr + fr) * 128 + ((fq ^ sw) << 4));
    unsigned bro = 65536u + (unsigned)((32 * wc + fr) * 128 + ((fq ^ sw) << 4));
    unsigned ldsA = (unsigned)(wid * 4096);
#define G_ISSUE_A(T) do { _Pragma("unroll") for (int p = 0; p < 4; ++p) \
        __builtin_amdgcn_global_load_lds((const unsigned*)(ap[p] + (T) * 128), (LAS unsigned*)(lds + ldsA + p * 1024), 16, 0, 0); } while (0)
#define G_LOAD_B(T) do { _Pragma("unroll") for (int j = 0; j < 8; ++j) breg[j] = *(const f32x4*)(bp + (size_t)((T) * 64 + j) * ldb); } while (0)
#define G_WRITE_B() do { _Pragma("unroll") for (int c = 0; c < 4; ++c) { u32x4 w; w.x = pk_bf16(breg[0][c], breg[1][c]); w.y = pk_bf16(breg[2][c], breg[3][c]); \
        w.z = pk_bf16(breg[4][c], breg[5][c]); w.w = pk_bf16(breg[6][c], breg[7][c]); *(LAS u32x4*)(lds + bw[c]) = w; } } while (0)
#define G_COMPUTE() do { _Pragma("unroll") for (int kk = 0; kk < 2; ++kk) { bf16x8 bf[2][2]; \
        _Pragma("unroll") for (int bj = 0; bj < 2; ++bj) _Pragma("unroll") for (int n = 0; n < 2; ++n) bf[bj][n] = *(const LAS bf16x8*)(lds + (bro ^ (kk * 64 + (n & 1) * 16)) + (128 * bj + 16 * n) * 128); \
        _Pragma("unroll") for (int ai = 0; ai < 2; ++ai) { bf16x8 af[4]; \
            _Pragma("unroll") for (int m = 0; m < 4; ++m) af[m] = *(const LAS bf16x8*)(lds + (aro ^ (kk * 64 + (m & 1) * 16)) + (128 * ai + 16 * m) * 128); \
            _Pragma("unroll") for (int bj = 0; bj < 2; ++bj) _Pragma("unroll") for (int m = 0; m < 4; ++m) _Pragma("unroll") for (int n = 0; n < 2; ++n) \
                acc[ai][bj][m][n] = __builtin_amdgcn_mfma_f32_16x16x32_bf16(bf[bj][n], af[m], acc[ai][bj][m][n], 0, 0, 0); \
            __builtin_amdgcn_sched_barrier(0); } } } while (0)
    G_ISSUE_A(0); G_LOAD_B(0); G_WRITE_B(); WG_BARRIER();
#pragma unroll 1
    for (int t = 0; t < GNT; ++t) {
        ldsA ^= 32768u;
#pragma unroll
        for (int c = 0; c < 4; ++c) bw[c] ^= 32768u;
        if (t + 1 < GNT) { G_ISSUE_A(t + 1); G_LOAD_B(t + 1); }
        __builtin_amdgcn_sched_barrier(0);
        G_COMPUTE();
        if (t + 1 < GNT) { G_WRITE_B(); }
        WG_BARRIER();
        aro ^= 32768u; bro ^= 32768u;
    }
    epi(acc, wr, wc, fr, fq);
#undef G_ISSUE_A
#undef G_LOAD_B
#undef G_WRITE_B
#undef G_COMPUTE
}

typedef f32x4 Acc[2][2][4][2];
#define EPI_LOOP_ROWS for (int ai = 0; ai < 2; ++ai) _Pragma("unroll") for (int m = 0; m < 4; ++m)
struct EpiIn { bf16_t* out; int row0, col0; bool act;
    __device__ __forceinline__ void operator()(const Acc& acc, int wr, int wc, int fr, int fq) const {
#pragma unroll
        EPI_LOOP_ROWS { const int row = row0 + 128 * ai + 64 * wr + 16 * m + fr;
#pragma unroll
            for (int bj = 0; bj < 2; ++bj) { f32x4 v0 = acc[ai][bj][m][0], v1 = acc[ai][bj][m][1];
                if (act) {
#pragma unroll
                    for (int r = 0; r < 4; ++r) { v0[r] = gelu_tanh(v0[r]); v1[r] = gelu_tanh(v1[r]); } }
                u32x4 w; w.x = pk_bf16(v0[0], v0[1]); w.y = pk_bf16(v0[2], v0[3]); w.z = pk_bf16(v1[0], v1[1]); w.w = pk_bf16(v1[2], v1[3]);
                *(u32x4*)(out + (size_t)row * INC + col0 + 128 * bj + 32 * wc + 8 * fq) = w; } }
    } };
struct EpiKV { bf16_t* km; bf16_t* vt; int row0, col0;
    __device__ __forceinline__ void operator()(const Acc& acc, int wr, int wc, int fr, int fq) const {
#pragma unroll
        EPI_LOOP_ROWS { const int row = row0 + 128 * ai + 64 * wr + 16 * m + fr;
#pragma unroll
            for (int bj = 0; bj < 2; ++bj) { const f32x4 v0 = acc[ai][bj][m][0], v1 = acc[ai][bj][m][1]; const int col = col0 + 128 * bj + 32 * wc + 8 * fq;
                if (col0 < DM) { u32x4 w; w.x = pk_bf16(v0[0], v0[1]); w.y = pk_bf16(v0[2], v0[3]); w.z = pk_bf16(v1[0], v1[1]); w.w = pk_bf16(v1[2], v1[3]);
                    *(u32x4*)(km + (size_t)row * DM + col) = w; }
                else { const int b = row >> 8, mm = row & 255; bf16_t* base = vt + ((size_t)(b * DM + (col - DM))) * MEML + mm;
#pragma unroll
                    for (int r = 0; r < 4; ++r) { base[(size_t)r * MEML] = (bf16_t)(pk_bf16(v0[r], 0.f) & 0xffffu); base[(size_t)(4 + r) * MEML] = (bf16_t)(pk_bf16(v1[r], 0.f) & 0xffffu); } } } }
    } };
struct EpiResid { const float* xprev; float* out; int row0, col0;
    __device__ __forceinline__ void operator()(const Acc& acc, int wr, int wc, int fr, int fq) const {
#pragma unroll
        EPI_LOOP_ROWS { const int row = row0 + 128 * ai + 64 * wr + 16 * m + fr;
#pragma unroll
            for (int bj = 0; bj < 2; ++bj) { const size_t off = (size_t)row * DM + col0 + 128 * bj + 32 * wc + 8 * fq;
                const f32x4 x0 = *(const f32x4*)(xprev + off), x1 = *(const f32x4*)(xprev + off + 4);
                *(f32x4*)(out + off) = x0 * ALPHA + acc[ai][bj][m][0]; *(f32x4*)(out + off + 4) = x1 * ALPHA + acc[ai][bj][m][1]; } }
    } };
struct EpiBf { bf16_t* out; int row0, col0; float scale;
    __device__ __forceinline__ void operator()(const Acc& acc, int wr, int wc, int fr, int fq) const {
#pragma unroll
        EPI_LOOP_ROWS { const int row = row0 + 128 * ai + 64 * wr + 16 * m + fr;
#pragma unroll
            for (int bj = 0; bj < 2; ++bj) { const f32x4 v0 = acc[ai][bj][m][0] * scale, v1 = acc[ai][bj][m][1] * scale;
                u32x4 w; w.x = pk_bf16(v0[0], v0[1]); w.y = pk_bf16(v0[2], v0[3]); w.z = pk_bf16(v1[0], v1[1]); w.w = pk_bf16(v1[2], v1[3]);
                *(u32x4*)(out + (size_t)row * DM + col0 + 128 * bj + 32 * wc + 8 * fq) = w; } }
    } };
struct EpiSwiglu { bf16_t* out; const float* bgu; int row0, colg;
    __device__ __forceinline__ void operator()(const Acc& acc, int wr, int wc, int fr, int fq) const {
        const int c = colg + 32 * wc + 8 * fq;
        const f32x4 bg0 = *(const f32x4*)(bgu + c), bg1 = *(const f32x4*)(bgu + c + 4), bu0 = *(const f32x4*)(bgu + DM + c), bu1 = *(const f32x4*)(bgu + DM + c + 4);
#pragma unroll
        EPI_LOOP_ROWS { const int row = row0 + 128 * ai + 64 * wr + 16 * m + fr;
            f32x4 o[2];
#pragma unroll
            for (int n = 0; n < 2; ++n) { const f32x4 g4 = acc[ai][0][m][n] + (n ? bg1 : bg0), u4 = acc[ai][1][m][n] + (n ? bu1 : bu0);
#pragma unroll
                for (int r = 0; r < 4; ++r) { const float g = fminf(g4[r], 7.0f), u = fminf(fmaxf(u4[r], -7.0f), 7.0f);
                    const float sg = fast_rcp(1.0f + fast_exp2(-1.702f * 1.4426950408889634f * g));
                    o[n][r] = (u + 1.0f) * (g * sg); } }
            u32x4 w; w.x = pk_bf16(o[0][0], o[0][1]); w.y = pk_bf16(o[0][2], o[0][3]); w.z = pk_bf16(o[1][0], o[1][1]); w.w = pk_bf16(o[1][2], o[1][3]);
            *(u32x4*)(out + (size_t)row * DM + c) = w; }
    } };
struct EpiDown { bf16_t* out; const float* bd; const float* gate; int row0, col0;
    __device__ __forceinline__ void operator()(const Acc& acc, int wr, int wc, int fr, int fq) const {
#pragma unroll
        EPI_LOOP_ROWS { const int tr = 128 * ai + 64 * wr + 16 * m + fr; const float gt = gate[tr];
#pragma unroll
            for (int bj = 0; bj < 2; ++bj) { const int col = col0 + 128 * bj + 32 * wc + 8 * fq;
                const f32x4 v0 = (acc[ai][bj][m][0] + *(const f32x4*)(bd + col)) * gt, v1 = (acc[ai][bj][m][1] + *(const f32x4*)(bd + col + 4)) * gt;
                u32x4 w; w.x = pk_bf16(v0[0], v0[1]); w.y = pk_bf16(v0[2], v0[3]); w.z = pk_bf16(v1[0], v1[1]); w.w = pk_bf16(v1[2], v1[3]);
                *(u32x4*)(out + (size_t)(row0 + tr) * DM + col) = w; } }
    } };

#ifndef PHM
#define PHM 0xFFFF
#endif
#define PH(k) ((PHM >> (k)) & 1)
struct Params { const float* in[20]; float* out; unsigned char* ws; };

__device__ __forceinline__ void ln_row(const float* src, const float* g, const float* b, float* dst, bf16_t* dstb, int lane) {
    f32x4 v[4]; float s = 0.f;
#pragma unroll
    for (int j = 0; j < 4; ++j) { v[j] = *(const f32x4*)(src + 256 * j + 4 * lane); s += (v[j][0] + v[j][1]) + (v[j][2] + v[j][3]); }
    const float mean = wave_sum(s) * (1.0f / DM); float q = 0.f;
#pragma unroll
    for (int j = 0; j < 4; ++j) { v[j] = v[j] - mean; q += (v[j][0] * v[j][0] + v[j][1] * v[j][1]) + (v[j][2] * v[j][2] + v[j][3] * v[j][3]); }
    const float rstd = 1.0f / sqrtf(wave_sum(q) * (1.0f / DM) + LN_EPS);
#pragma unroll
    for (int j = 0; j < 4; ++j) { const f32x4 gg = *(const f32x4*)(g + 256 * j + 4 * lane), bb = *(const f32x4*)(b + 256 * j + 4 * lane);
        const f32x4 o = v[j] * rstd * gg + bb; *(f32x4*)(dst + 256 * j + 4 * lane) = o;
        u32x2 w; w.x = pk_bf16(o[0], o[1]); w.y = pk_bf16(o[2], o[3]); *(u32x2*)(dstb + 256 * j + 4 * lane) = w; }
}

__global__ void __launch_bounds__(512, 2) mega_fwd(Params P) {
    extern __shared__ __attribute__((aligned(16))) unsigned char lds_raw[];
    LAS unsigned char* lds = (LAS unsigned char*)lds_raw;
#define PHASE_IDS() int tid = threadIdx.x; asm volatile("" : "+v"(tid)); const int lane = tid & 63, wid = __builtin_amdgcn_readfirstlane(tid >> 6); (void)lane; (void)wid
    const int G = gridDim.x, bx = blockIdx.x;
    const int vcu = (G % 8 == 0) ? (bx % 8) * (G / 8) + bx / 8 : bx;
    unsigned char* ws = P.ws;
    unsigned* ctl = (unsigned*)(ws + WS_CTL);
    volatile LAS unsigned* misc = (volatile LAS unsigned*)(lds + LDS_MISC);
    { PHASE_IDS(); if (tid < 64) misc[tid] = 0u; }
    __syncthreads();
    XcdBarrier bar = xcd_barrier_post(ctl + CW_BAR, misc + 8);
#define GRID_BAR() xcd_barrier(bar)

    bf16_t* XB = (bf16_t*)(ws + WS_XB); bf16_t* MEMB = (bf16_t*)(ws + WS_MEMB); bf16_t* PROJ = (bf16_t*)(ws + WS_PROJ);
    bf16_t* KM = (bf16_t*)(ws + WS_KM); bf16_t* VT = (bf16_t*)(ws + WS_VT); bf16_t* YMIX = (bf16_t*)(ws + WS_YMIX);
    float* SBUF = (float*)(ws + WS_SBUF); float* X1 = (float*)(ws + WS_X1); bf16_t* X1B = (bf16_t*)(ws + WS_X1B);
    bf16_t* QM = (bf16_t*)(ws + WS_QM); bf16_t* OM = (bf16_t*)(ws + WS_OM); float* X2 = (float*)(ws + WS_X2); bf16_t* X2B = (bf16_t*)(ws + WS_X2B);
    bf16_t* ABUF = (bf16_t*)(ws + WS_ABUF); bf16_t* YBUF = (bf16_t*)(ws + WS_YBUF); float* X3 = (float*)(ws + WS_X3);

    {
        PHASE_IDS();
        const float* x = P.in[0]; const float* mem = P.in[1];
        const int nthr = G * 512, gt = bx * 512 + tid;
        for (int i = gt; i < NTOK * DM / 4; i += nthr) { const f32x4 v = *(const f32x4*)(x + (size_t)i * 4); u32x2 w; w.x = pk_bf16(v[0], v[1]); w.y = pk_bf16(v[2], v[3]); *(u32x2*)(XB + (size_t)i * 4) = w; }
        for (int i = gt; i < MEMROWS * DM / 4; i += nthr) { const f32x4 v = *(const f32x4*)(mem + (size_t)i * 4); u32x2 w; w.x = pk_bf16(v[0], v[1]); w.y = pk_bf16(v[2], v[3]); *(u32x2*)(MEMB + (size_t)i * 4) = w; }
    }
    GRID_BAR();

#pragma unroll 1
    for (int l = 0; l < DEPTH; ++l) {
        const float* xin = (l == 0) ? P.in[0] : X3;
        float* xout = (l == DEPTH - 1) ? P.out : X3;
        const float* w_in = P.in[2] + (size_t)l * DM * INC;
        const float* sgu_g = P.in[3] + l * 512; const float* sgu_b = P.in[4] + l * 512;
        const float* w_sp = P.in[5] + (size_t)l * 4 * 128 * 128; const float* b_sp = P.in[6] + l * 4 * 128;
        const float* grp_g = P.in[7] + l * DM;
        const float* w_out = P.in[8] + (size_t)l * DM * DM;
        const float* wq = P.in[9] + (size_t)l * DM * DM; const float* wkv = P.in[10] + (size_t)l * DM * 2 * DM; const float* wo = P.in[11] + (size_t)l * DM * DM;
        const float* w_router = P.in[12] + (size_t)l * DM * NE; const float* b_router = P.in[13] + l * NE;
        const float* w_gu = P.in[14] + (size_t)l * NE * DM * 2 * DM; const float* b_gu = P.in[15] + (size_t)l * NE * 2 * DM;
        const float* w_down = P.in[16] + (size_t)l * NE * DM * DM; const float* b_down = P.in[17] + (size_t)l * NE * DM;
        const float* ln_g = P.in[18] + l * 3 * DM; const float* ln_b = P.in[19] + l * 3 * DM;
        unsigned* cnt = ctl + CW_CNT + l * 64;
        int* list_tok = (int*)(ws + WS_ROUTE + l * ROUTE_LAYER); float* list_gate = (float*)(ws + WS_ROUTE + l * ROUTE_LAYER + 2 * MiB); int* sel = (int*)(ws + WS_ROUTE + l * ROUTE_LAYER + 4 * MiB);

        if (PH(1))
#pragma unroll 1
        for (int u = vcu; u < 704; u += G) {
            if (u < 640) { const int ct = u >> 6, rt = u & 63;
                EpiIn E{PROJ, 256 * rt, 256 * ct, ct < 4}; RowLinear rm{256 * rt};
                gemm_tile(lds, XB, DM, rm, w_in, INC, 256 * ct, 256 * ct + 128, E);
            } else { const int v = u - 640, ct = v >> 3, rt = v & 7;
                EpiKV E{KM, VT, 256 * rt, 256 * ct}; RowLinear rm{256 * rt};
                gemm_tile(lds, MEMB, DM, rm, wkv, 2 * DM, 256 * ct, 256 * ct + 128, E);
            }
        }
        GRID_BAR();

        if (PH(2))
        {
            PHASE_IDS();
#pragma unroll 1
            for (int u = vcu; u < 512; u += G) {
                const int g = u & 3, c = (u >> 2) & 15, b = u >> 6; const int tok0 = b * SEQ + 128 * c;
                {
                    const int tp = tid >> 3, cg = tid & 7;
                    float vv[2][16];
#pragma unroll
                    for (int s = 0; s < 2; ++s) { const bf16_t* src = PROJ + (size_t)(tok0 + 2 * tp + s) * INC + 512 + 128 * g + 16 * cg;
                        const u32x4 a = *(const u32x4*)src, bq = *(const u32x4*)(src + 8);
#pragma unroll
                        for (int e = 0; e < 4; ++e) { vv[s][2 * e] = bf2f(a[e] & 0xffffu); vv[s][2 * e + 1] = bf2f(a[e] >> 16); vv[s][8 + 2 * e] = bf2f(bq[e] & 0xffffu); vv[s][8 + 2 * e + 1] = bf2f(bq[e] >> 16); }
                        float sm = 0.f;
#pragma unroll
                        for (int e = 0; e < 16; ++e) sm += vv[s][e];
                        sm += __shfl_xor(sm, 1); sm += __shfl_xor(sm, 2); sm += __shfl_xor(sm, 4);
                        const float mean = sm * (1.0f / 128.0f); float q = 0.f;
#pragma unroll
                        for (int e = 0; e < 16; ++e) { vv[s][e] -= mean; q += vv[s][e] * vv[s][e]; }
                        q += __shfl_xor(q, 1); q += __shfl_xor(q, 2); q += __shfl_xor(q, 4);
                        const float rstd = 1.0f / sqrtf(q * (1.0f / 128.0f) + LN_EPS);
#pragma unroll
                        for (int e = 0; e < 16; ++e) vv[s][e] = vv[s][e] * rstd * sgu_g[128 * g + 16 * cg + e] + sgu_b[128 * g + 16 * cg + e];
                    }
                    const int s0 = 2 * tp, chunk = s0 >> 3;
#pragma unroll
                    for (int e = 0; e < 16; ++e) { const int d = 16 * cg + e;
                        *(LAS unsigned*)(lds + d * 256 + ((chunk ^ (d & 15)) << 4) + (s0 & 7) * 2) = pk_bf16(vv[0][e], vv[1][e]); }
                }
                WG_BARRIER();
                {
                    const int fr = lane & 15, fq = lane >> 4, t = 16 * wid + fr;
                    f32x4 acc[8];
#pragma unroll
                    for (int nb = 0; nb < 8; ++nb) acc[nb] = (f32x4){0.f, 0.f, 0.f, 0.f};
                    const float* wrow = w_sp + ((size_t)g * 128 + t) * 128;
                    const int nkk = (wid >> 1) + 1;
#pragma unroll 1
                    for (int kk = 0; kk < nkk; ++kk) {
                        const int sb = 32 * kk + 8 * fq;
                        const f32x4 w0 = *(const f32x4*)(wrow + sb), w1 = *(const f32x4*)(wrow + sb + 4);
                        float wv[8] = {w0[0], w0[1], w0[2], w0[3], w1[0], w1[1], w1[2], w1[3]};
#pragma unroll
                        for (int j = 0; j < 8; ++j) wv[j] = (sb + j <= t) ? wv[j] : 0.f;
                        u32x4 wp; wp.x = pk_bf16(wv[0], wv[1]); wp.y = pk_bf16(wv[2], wv[3]); wp.z = pk_bf16(wv[4], wv[5]); wp.w = pk_bf16(wv[6], wv[7]);
                        const bf16x8 wf = __builtin_bit_cast(bf16x8, wp);
#pragma unroll
                        for (int nb = 0; nb < 8; ++nb) { const int d = 16 * nb + fr;
                            const bf16x8 vf = *(const LAS bf16x8*)(lds + d * 256 + ((((4 * kk + fq) ^ (d & 15))) << 4));
                            acc[nb] = __builtin_amdgcn_mfma_f32_16x16x32_bf16(vf, wf, acc[nb], 0, 0, 0); }
                    }
                    const float bias = b_sp[g * 128 + t];
                    const bf16_t* urow = PROJ + (size_t)(tok0 + t) * INC + 128 * g;
                    float ms = 0.f;
#pragma unroll
                    for (int nb = 0; nb < 8; ++nb) { const u32x2 uu = *(const u32x2*)(urow + 16 * nb + 4 * fq);
                        const float u0 = bf2f(uu.x & 0xffffu), u1 = bf2f(uu.x >> 16), u2 = bf2f(uu.y & 0xffffu), u3 = bf2f(uu.y >> 16);
                        acc[nb][0] = u0 * (acc[nb][0] + bias); acc[nb][1] = u1 * (acc[nb][1] + bias); acc[nb][2] = u2 * (acc[nb][2] + bias); acc[nb][3] = u3 * (acc[nb][3] + bias);
                        ms += (acc[nb][0] * acc[nb][0] + acc[nb][1] * acc[nb][1]) + (acc[nb][2] * acc[nb][2] + acc[nb][3] * acc[nb][3]); }
                    ms += __shfl_xor(ms, 16); ms += __shfl_xor(ms, 32);
                    const float sc = 1.0f / sqrtf(ms * (1.0f / 128.0f) + RMS_EPS);
                    bf16_t* yrow = YMIX + (size_t)(tok0 + t) * DM + 128 * g;
#pragma unroll
                    for (int nb = 0; nb < 8; ++nb) { const f32x4 gg = *(const f32x4*)(grp_g + 128 * g + 16 * nb + 4 * fq); const f32x4 o = acc[nb] * sc * gg;
                        u32x2 w; w.x = pk_bf16(o[0], o[1]); w.y = pk_bf16(o[2], o[3]); *(u32x2*)(yrow + 16 * nb + 4 * fq) = w; }
                }
                WG_BARRIER();
            }
#pragma unroll 1
            for (int pp = 2 * vcu; pp < 1024; pp = ((pp & 1) ? pp + 2 * G - 1 : pp + 1)) {
                const int pr = pp >> 1, bh = pr >> 3, ip = pr & 7, qi = (pp & 1) ? (15 - ip) : ip;
                const int b = bh >> 3, h = bh & 7; const int tokb = b * SEQ;
                const int fr = lane & 15, fq = lane >> 4, tq = 128 * qi + 16 * wid + fr;
                bf16x8 qf[2];
#pragma unroll
                for (int kk = 0; kk < 2; ++kk) qf[kk] = *(const bf16x8*)(PROJ + (size_t)(tokb + tq) * INC + 1024 + 64 * h + 32 * kk + 8 * fq);
                f32x4 oacc[4];
#pragma unroll
                for (int db = 0; db < 4; ++db) oacc[db] = (f32x4){0.f, 0.f, 0.f, 0.f};
                float R = 0.f;
                const int ntile = 2 * qi + 2;
#pragma unroll 1
                for (int jt = ntile - 1; jt >= 0; --jt) {
                    LAS unsigned char* vbuf = lds + (jt & 1) * 8704;
                    {
                        const int kv = tid >> 3, ch = tid & 7;
                        const u32x4 a = *(const u32x4*)(PROJ + (size_t)(tokb + 64 * jt + kv) * INC + 2048 + 64 * h + 8 * ch);
#pragma unroll
                        for (int e = 0; e < 4; ++e) { *(LAS bf16_t*)(vbuf + (8 * ch + 2 * e) * 136 + 2 * kv) = (bf16_t)(a[e] & 0xffffu); *(LAS bf16_t*)(vbuf + (8 * ch + 2 * e + 1) * 136 + 2 * kv) = (bf16_t)(a[e] >> 16); }
                    }
                    WG_BARRIER();
                    if (64 * jt < 128 * qi + 16 * wid + 15) {
                        f32x4 z[4];
#pragma unroll
                        for (int nb = 0; nb < 4; ++nb) { z[nb] = (f32x4){0.f, 0.f, 0.f, 0.f};
#pragma unroll
                            for (int kk = 0; kk < 2; ++kk) { const bf16x8 kf = *(const bf16x8*)(PROJ + (size_t)(tokb + 64 * jt + 16 * nb + fr) * INC + 1536 + 64 * h + 32 * kk + 8 * fq);
                                z[nb] = __builtin_amdgcn_mfma_f32_16x16x32_bf16(kf, qf[kk], z[nb], 0, 0, 0); } }
                        float lnot[4][4], lsig[4][4], gsum[4];
#pragma unroll
                        for (int nb = 0; nb < 4; ++nb) { gsum[nb] = 0.f;
#pragma unroll
                            for (int r = 0; r < 4; ++r) { const float zz = z[nb][r] * 0.125f; const int s = 64 * jt + 16 * nb + 4 * fq + r;
                                const float sp = fmaxf(zz, 0.f) + 0.6931471805599453f * fast_log2(1.0f + fast_exp2(-1.4426950408889634f * fabsf(zz)));
                                const bool valid = s < tq;
                                lnot[nb][r] = valid ? -sp : 0.f; lsig[nb][r] = valid ? (zz - sp) : -1.0e30f; gsum[nb] += lnot[nb][r]; } }
                        float off = R;
                        u32x4 pw[2];
#pragma unroll
                        for (int nb = 3; nb >= 0; --nb) {
                            const float x1 = __shfl_xor(gsum[nb], 16), x2 = __shfl_xor(gsum[nb], 32), x3 = __shfl_xor(gsum[nb], 48);
                            const float tot = (gsum[nb] + x1) + (x2 + x3);
                            const float suf = ((fq & 1) ? 0.f : x1) + ((fq & 2) ? 0.f : (x2 + x3));
                            float c3 = off + suf, c2 = c3 + lnot[nb][3], c1 = c2 + lnot[nb][2], c0 = c1 + lnot[nb][1];
                            const float p0 = fast_exp2(1.4426950408889634f * (lsig[nb][0] + c0)), p1 = fast_exp2(1.4426950408889634f * (lsig[nb][1] + c1));
                            const float p2 = fast_exp2(1.4426950408889634f * (lsig[nb][2] + c2)), p3 = fast_exp2(1.4426950408889634f * (lsig[nb][3] + c3));
                            const unsigned lo = pk_bf16(p0, p1), hi = pk_bf16(p2, p3);
                            if (nb == 0) { pw[0].x = lo; pw[0].y = hi; } else if (nb == 1) { pw[0].z = lo; pw[0].w = hi; } else if (nb == 2) { pw[1].x = lo; pw[1].y = hi; } else { pw[1].z = lo; pw[1].w = hi; }
                            off += tot;
                        }
                        R = off;
#pragma unroll
                        for (int kk = 0; kk < 2; ++kk) { const bf16x8 pf = __builtin_bit_cast(bf16x8, pw[kk]);
#pragma unroll
                            for (int db = 0; db < 4; ++db) { const LAS unsigned char* vp = vbuf + (16 * db + fr) * 136 + (32 * kk + 4 * fq) * 2;
                                const u32x2 v0 = *(const LAS u32x2*)vp, v1 = *(const LAS u32x2*)(vp + 32);
                                u32x4 vv; vv.x = v0.x; vv.y = v0.y; vv.z = v1.x; vv.w = v1.y;
                                oacc[db] = __builtin_amdgcn_mfma_f32_16x16x32_bf16(__builtin_bit_cast(bf16x8, vv), pf, oacc[db], 0, 0, 0); } }
                    }
                }
                float ms = 0.f;
#pragma unroll
                for (int db = 0; db < 4; ++db) ms += (oacc[db][0] * oacc[db][0] + oacc[db][1] * oacc[db][1]) + (oacc[db][2] * oacc[db][2] + oacc[db][3] * oacc[db][3]);
                ms += __shfl_xor(ms, 16); ms += __shfl_xor(ms, 32);
                const float sc = 1.0f / sqrtf(ms * (1.0f / 64.0f) + RMS_EPS);
                bf16_t* yrow = YMIX + (size_t)(tokb + tq) * DM + 512 + 64 * h;
#pragma unroll
                for (int db = 0; db < 4; ++db) { const f32x4 gg = *(const f32x4*)(grp_g + 512 + 64 * h + 16 * db + 4 * fq); const f32x4 o = oacc[db] * sc * gg;
                    u32x2 w; w.x = pk_bf16(o[0], o[1]); w.y = pk_bf16(o[2], o[3]); *(u32x2*)(yrow + 16 * db + 4 * fq) = w; }
                WG_BARRIER();
            }
        }
        GRID_BAR();

        if (PH(3))
#pragma unroll 1
        for (int u = vcu; u < 256; u += G) { const int ct = u >> 6, rt = u & 63;
            EpiResid E{xin, SBUF, 256 * rt, 256 * ct}; RowLinear rm{256 * rt};
            gemm_tile(lds, YMIX, DM, rm, w_out, DM, 256 * ct, 256 * ct + 128, E); }
        GRID_BAR();
        if (PH(4))
        { PHASE_IDS();
#pragma unroll 1
        for (int row = vcu * 8 + wid; row < NTOK; row += G * 8) ln_row(SBUF + (size_t)row * DM, ln_g, ln_b, X1 + (size_t)row * DM, X1B + (size_t)row * DM, lane); }
        GRID_BAR();
        if (PH(5))
#pragma unroll 1
        for (int u = vcu; u < 256; u += G) { const int ct = u >> 6, rt = u & 63;
            EpiBf E{QM, 256 * rt, 256 * ct, 0.0625f}; RowLinear rm{256 * rt};
            gemm_tile(lds, X1B, DM, rm, wq, DM, 256 * ct, 256 * ct + 128, E); }
        GRID_BAR();
        if (PH(6))
#pragma unroll 1
        for (int u = vcu; u < 512; u += G) {
            PHASE_IDS();
            const int qb = u & 15, h = (u >> 4) & 3, b = u >> 6;
            const int fr = lane & 15, fq = lane >> 4, tq = b * SEQ + 128 * qb + 16 * wid + fr;
            f32x4 sacc[16];
            {
                bf16x8 qf[8];
#pragma unroll
                for (int kk = 0; kk < 8; ++kk) qf[kk] = *(const bf16x8*)(QM + (size_t)tq * DM + 256 * h + 32 * kk + 8 * fq);
#pragma unroll
                for (int mb = 0; mb < 16; ++mb) { sacc[mb] = (f32x4){0.f, 0.f, 0.f, 0.f};
                    const bf16_t* krow = KM + (size_t)(b * MEML + 16 * mb + fr) * DM + 256 * h + 8 * fq;
#pragma unroll
                    for (int kk = 0; kk < 8; ++kk) { const bf16x8 kf = *(const bf16x8*)(krow + 32 * kk); sacc[mb] = __builtin_amdgcn_mfma_f32_16x16x32_bf16(kf, qf[kk], sacc[mb], 0, 0, 0); } }
            }
            float mx = -3.0e38f;
#pragma unroll
            for (int mb = 0; mb < 16; ++mb) mx = fmaxf(mx, fmaxf(fmaxf(sacc[mb][0], sacc[mb][1]), fmaxf(sacc[mb][2], sacc[mb][3])));
            mx = fmaxf(mx, __shfl_xor(mx, 16)); mx = fmaxf(mx, __shfl_xor(mx, 32));
            float den = 0.f; u32x4 pw[8];
#pragma unroll
            for (int mb = 0; mb < 16; ++mb) {
                const float p0 = fast_exp2(1.4426950408889634f * (sacc[mb][0] - mx)), p1 = fast_exp2(1.4426950408889634f * (sacc[mb][1] - mx));
                const float p2 = fast_exp2(1.4426950408889634f * (sacc[mb][2] - mx)), p3 = fast_exp2(1.4426950408889634f * (sacc[mb][3] - mx));
                den += (p0 + p1) + (p2 + p3);
                const unsigned lo = pk_bf16(p0, p1), hi = pk_bf16(p2, p3);
                if (mb & 1) { pw[mb >> 1].z = lo; pw[mb >> 1].w = hi; } else { pw[mb >> 1].x = lo; pw[mb >> 1].y = hi; }
            }
            den += __shfl_xor(den, 16); den += __shfl_xor(den, 32);
            const float rden = 1.0f / den;
            bf16_t* orow = OM + (size_t)tq * DM + 256 * h;
#pragma unroll 2
            for (int db = 0; db < 16; ++db) {
                f32x4 o = (f32x4){0.f, 0.f, 0.f, 0.f};
                const bf16_t* vrow = VT + ((size_t)(b * DM + 256 * h + 16 * db + fr)) * MEML + 4 * fq;
#pragma unroll
                for (int kk = 0; kk < 8; ++kk) { const u32x2 v0 = *(const u32x2*)(vrow + 32 * kk), v1 = *(const u32x2*)(vrow + 32 * kk + 16);
                    u32x4 vv; vv.x = v0.x; vv.y = v0.y; vv.z = v1.x; vv.w = v1.y;
                    o = __builtin_amdgcn_mfma_f32_16x16x32_bf16(__builtin_bit_cast(bf16x8, vv), __builtin_bit_cast(bf16x8, pw[kk]), o, 0, 0, 0); }
                o = o * rden;
                u32x2 w; w.x = pk_bf16(o[0], o[1]); w.y = pk_bf16(o[2], o[3]); *(u32x2*)(orow + 16 * db + 4 * fq) = w;
            }
        }
        GRID_BAR();
        if (PH(7))
#pragma unroll 1
        for (int u = vcu; u < 256; u += G) { const int ct = u >> 6, rt = u & 63;
            EpiResid E{X1, SBUF, 256 * rt, 256 * ct}; RowLinear rm{256 * rt};
            gemm_tile(lds, OM, DM, rm, wo, DM, 256 * ct, 256 * ct + 128, E); }
        GRID_BAR();
        if (PH(8))
#pragma unroll 1
        for (int ch = vcu; ch < NTOK / 64; ch += G) {
            PHASE_IDS();
            const int r0 = ch * 64;
#pragma unroll 1
            for (int i = 0; i < 8; ++i) { const int row = r0 + 8 * wid + i; ln_row(SBUF + (size_t)row * DM, ln_g + DM, ln_b + DM, X2 + (size_t)row * DM, X2B + (size_t)row * DM, lane); }
            WG_BARRIER();
            if (wid < 4) {
                const int fr = lane & 15, fq = lane >> 4, t0 = r0 + 16 * wid;
                f32x4 a0 = (f32x4){0.f, 0.f, 0.f, 0.f}, a1 = (f32x4){0.f, 0.f, 0.f, 0.f};
                const float* xr = X2 + (size_t)(t0 + fr) * DM + 4 * fq;
#pragma unroll 2
                for (int kb = 0; kb < 64; ++kb) {
                    const f32x4 xa = *(const f32x4*)(xr + 16 * kb);
                    const float* wrp = w_router + (size_t)(16 * kb + 4 * fq) * NE + fr;
#pragma unroll
                    for (int c = 0; c < 4; ++c) { a0 = __builtin_amdgcn_mfma_f32_16x16x4f32(xa[c], wrp[c * NE], a0, 0, 0, 0); a1 = __builtin_amdgcn_mfma_f32_16x16x4f32(xa[c], wrp[c * NE + 16], a1, 0, 0, 0); }
                }
                const float br0 = b_router[fr], br1 = b_router[16 + fr];
                float sv[4][4]; int si[4][4];
#pragma unroll
                for (int r = 0; r < 4; ++r) { float v0 = a0[r] + br0, v1 = a1[r] + br1;
#pragma unroll
                    for (int k = 0; k < 4; ++k) { float bv = (v0 >= v1) ? v0 : v1; int bi = (v0 >= v1) ? fr : 16 + fr;
#pragma unroll
                        for (int o = 1; o < 16; o <<= 1) { const float ov = __shfl_xor(bv, o); const int oi = __shfl_xor(bi, o); const bool take = (ov > bv) || (ov == bv && oi < bi); bv = take ? ov : bv; bi = take ? oi : bi; }
                        sv[r][k] = bv; si[r][k] = bi; if (bi == fr) v0 = -3.0e38f; if (bi == 16 + fr) v1 = -3.0e38f; } }
                if (fr < 4) {
#pragma unroll
                    for (int r = 0; r < 4; ++r) {
                        const float e1 = fast_exp2(1.4426950408889634f * (sv[r][1] - sv[r][0])), e2 = fast_exp2(1.4426950408889634f * (sv[r][2] - sv[r][0])), e3 = fast_exp2(1.4426950408889634f * (sv[r][3] - sv[r][0]));
                        const float inv = 1.0f / (((1.0f + e1) + e2) + e3);
                        const float mye = (fr == 0) ? 1.0f : (fr == 1) ? e1 : (fr == 2) ? e2 : e3;
                        const int myi = (fr == 0) ? si[r][0] : (fr == 1) ? si[r][1] : (fr == 2) ? si[r][2] : si[r][3];
                        const int tok = t0 + 4 * fq + r;
                        const unsigned pos = atomicAdd(cnt + myi, 1u);
                        list_tok[(size_t)myi * NTOK + pos] = tok; list_gate[(size_t)myi * NTOK + pos] = mye * inv; sel[tok * 4 + fr] = myi * NTOK + (int)pos;
                    }
                }
            }
            WG_BARRIER();
        }
        GRID_BAR();
        LAS int* tab = (LAS int*)(lds + LDS_TAB);
        if (threadIdx.x == 0) { int rb = 0, tp = 0;
            for (int e = 0; e < NE; ++e) { const int c = (int)xb_ld(cnt + e); const int nt = (c + 255) >> 8; tab[e] = c; tab[32 + e] = nt; tab[64 + e] = rb; tab[96 + e] = tp; rb += nt * 256; tp += nt; }
            tab[96 + NE] = tp; }
        WG_BARRIER();
        const int ntile_tot = tab[96 + NE];
        if (PH(9))
#pragma unroll 1
        for (int u = vcu; u < ntile_tot * 8; u += G) {
            int e = 0;
#pragma unroll 1
            for (int q = 1; q < NE; ++q) if (u >= tab[96 + q] * 8) e = q;
            const int v = u - tab[96 + e] * 8, nt = tab[32 + e], ct = v / nt, rt = v - ct * nt;
            RowList rm{list_tok + (size_t)e * NTOK + 256 * rt, tab[e] - 256 * rt};
            EpiSwiglu E{ABUF, b_gu + (size_t)e * 2 * DM, tab[64 + e] + 256 * rt, 128 * ct};
            gemm_tile(lds, X2B, DM, rm, w_gu + (size_t)e * DM * 2 * DM, 2 * DM, 128 * ct, DM + 128 * ct, E);
        }
        GRID_BAR();
        if (PH(10))
#pragma unroll 1
        for (int u = vcu; u < ntile_tot * 4; u += G) {
            int e = 0;
#pragma unroll 1
            for (int q = 1; q < NE; ++q) if (u >= tab[96 + q] * 4) e = q;
            const int v = u - tab[96 + e] * 4, nt = tab[32 + e], ct = v / nt, rt = v - ct * nt;
            RowLinear rm{tab[64 + e] + 256 * rt};
            EpiDown E{YBUF, b_down + (size_t)e * DM, list_gate + (size_t)e * NTOK + 256 * rt, tab[64 + e] + 256 * rt, 256 * ct};
            gemm_tile(lds, ABUF, DM, rm, w_down + (size_t)e * DM * DM, DM, 256 * ct, 256 * ct + 128, E);
        }
        GRID_BAR();
        if (PH(11))
#pragma unroll 1
        for (int row = vcu * 8 + (int)(threadIdx.x >> 6); row < NTOK; row += G * 8) {
            PHASE_IDS();
            int rows[4];
#pragma unroll
            for (int k = 0; k < 4; ++k) { const int s = sel[row * 4 + k]; const int e = s >> 14, pos = s & (NTOK - 1); rows[k] = tab[64 + e] + pos; }
            f32x4 v[4]; float sm = 0.f;
#pragma unroll
            for (int j = 0; j < 4; ++j) { v[j] = *(const f32x4*)(X2 + (size_t)row * DM + 256 * j + 4 * lane) * ALPHA;
#pragma unroll
                for (int k = 0; k < 4; ++k) { const u32x2 y = *(const u32x2*)(YBUF + (size_t)rows[k] * DM + 256 * j + 4 * lane);
                    v[j][0] += bf2f(y.x & 0xffffu); v[j][1] += bf2f(y.x >> 16); v[j][2] += bf2f(y.y & 0xffffu); v[j][3] += bf2f(y.y >> 16); }
                sm += (v[j][0] + v[j][1]) + (v[j][2] + v[j][3]); }
            const float mean = wave_sum(sm) * (1.0f / DM); float q = 0.f;
#pragma unroll
            for (int j = 0; j < 4; ++j) { v[j] = v[j] - mean; q += (v[j][0] * v[j][0] + v[j][1] * v[j][1]) + (v[j][2] * v[j][2] + v[j][3] * v[j][3]); }
            const float rstd = 1.0f / sqrtf(wave_sum(q) * (1.0f / DM) + LN_EPS);
#pragma unroll
            for (int j = 0; j < 4; ++j) { const f32x4 gg = *(const f32x4*)(ln_g + 2 * DM + 256 * j + 4 * lane), bb = *(const f32x4*)(ln_b + 2 * DM + 256 * j + 4 * lane);
                const f32x4 o = v[j] * rstd * gg + bb; *(f32x4*)(xout + (size_t)row * DM + 256 * j + 4 * lane) = o;
                u32x2 w; w.x = pk_bf16(o[0], o[1]); w.y = pk_bf16(o[2], o[3]); *(u32x2*)(XB + (size_t)row * DM + 256 * j + 4 * lane) = w; }
        }
        if (l + 1 < DEPTH) GRID_BAR();
    }
}

extern "C" void kernel_launch(void* const* d_in, const int* in_sizes, int n_in, void* d_out, int out_size, void* d_ws, size_t ws_size, hipStream_t stream) {
    static int grid = 0;
    if (grid == 0) {
        if (n_in != 20 || out_size != NTOK * DM || ws_size < WS_END) { fprintf(stderr, "kernel_launch: unexpected shapes (n_in %d, out %d, ws %zu)\n", n_in, out_size, ws_size); grid = -1; return; }
        int dev = 0, cus = 0;
        if (hipGetDevice(&dev) != hipSuccess || hipDeviceGetAttribute(&cus, hipDeviceAttributeMultiprocessorCount, dev) != hipSuccess) { grid = -1; return; }
        if (hipFuncSetAttribute((const void*)mega_fwd, hipFuncAttributeMaxDynamicSharedMemorySize, LDS_BYTES) != hipSuccess) { fprintf(stderr, "kernel_launch: hipFuncSetAttribute failed\n"); grid = -1; return; }
        (void)hipGetLastError();
        grid = cus;
    }
    if (grid < 0) return;
    (void)hipMemsetAsync((char*)d_ws + WS_CTL, 0, CTL_BYTES, stream);
    Params p{};
    for (int i = 0; i < 20; ++i) p.in[i] = (const float*)d_in[i];
    p.out = (float*)d_out; p.ws = (unsigned char*)d_ws;
    hipLaunchKernelGGL(mega_fwd, dim3(grid), dim3(512), LDS_BYTES, stream, p);
}
```

```cpp
#include <hip/hip_runtime.h>
#include <cstdio>
#include <cstdint>

#define LAS __attribute__((address_space(3)))
typedef unsigned short bf16_t;
typedef short bf16x8 __attribute__((ext_vector_type(8)));
typedef short s16x4 __attribute__((ext_vector_type(4)));
typedef float f32x4 __attribute__((ext_vector_type(4)));
typedef float f32x2 __attribute__((ext_vector_type(2)));
typedef unsigned u32x4 __attribute__((ext_vector_type(4)));
typedef unsigned u32x2 __attribute__((ext_vector_type(2)));
typedef __bf16 bf16x2_t __attribute__((ext_vector_type(2)));

constexpr int NB = 8, SEQ = 2048, DM = 1024, NTOK = NB * SEQ, DEPTH = 2;
constexpr int INC = 2560;
constexpr int MEML = 256, MEMROWS = NB * MEML;
constexpr int NE = 32, TOPK = 4;
constexpr int PROWS = NTOK * TOPK + NE * 256;
constexpr float ALPHA = 1.4142135623730951f;
constexpr float LN_EPS = 1e-5f, RMS_EPS = 1e-6f;

constexpr size_t MiB = 1u << 20;
constexpr size_t WS_CTL = 0, CTL_BYTES = 1 * MiB;
constexpr size_t WS_XB = 1 * MiB;
constexpr size_t WS_MEMB = 33 * MiB;
constexpr size_t WS_PROJ = 37 * MiB;
constexpr size_t WS_KM = 117 * MiB;
constexpr size_t WS_VT = 121 * MiB;
constexpr size_t WS_YMIX = 125 * MiB;
constexpr size_t WS_SBUF = 157 * MiB;
constexpr size_t WS_X1 = 221 * MiB;
constexpr size_t WS_X1B = 285 * MiB;
constexpr size_t WS_QM = 317 * MiB;
constexpr size_t WS_OM = 349 * MiB;
constexpr size_t WS_X2 = 381 * MiB;
constexpr size_t WS_X2B = 445 * MiB;
constexpr size_t WS_ROUTE = 477 * MiB;
constexpr size_t ROUTE_LAYER = 5 * MiB;
constexpr size_t WS_ABUF = 487 * MiB;
constexpr size_t WS_YBUF = 631 * MiB;
constexpr size_t WS_X3 = 775 * MiB;
constexpr size_t WS_END = 839 * MiB;
constexpr int CW_BAR = 4096;
constexpr int CW_CNT = 8192;

constexpr int LDS_TAB = 131072;
constexpr int LDS_MISC = 131072 + 2048;
constexpr int LDS_BYTES = 147456;

__device__ __forceinline__ float bf2f(unsigned h) { return __uint_as_float(h << 16); }
__device__ __forceinline__ unsigned pk_bf16(float lo, float hi) { f32x2 v = {lo, hi}; bf16x2_t b = __builtin_convertvector(v, bf16x2_t); return __builtin_bit_cast(unsigned, b); }
__device__ __forceinline__ float fast_exp2(float x) { return __builtin_amdgcn_exp2f(x); }
__device__ __forceinline__ float fast_log2(float x) { return __builtin_amdgcn_logf(x); }
__device__ __forceinline__ float fast_rcp(float x) { return __builtin_amdgcn_rcpf(x); }
__device__ __forceinline__ float fast_rsq(float x) { return __builtin_amdgcn_rsqf(x); }
__device__ __forceinline__ float gelu_tanh(float x) {
    const float y = 1.5957691216057308f * x * (1.0f + 0.044715f * x * x);
    return x * fast_rcp(1.0f + fast_exp2(-1.4426950408889634f * y));
}
__device__ __forceinline__ float wave_sum(float v) {
#pragma unroll
    for (int o = 1; o < 64; o <<= 1) v += __shfl_xor(v, o);
    return v;
}
#define VM_WAIT() asm volatile("s_waitcnt vmcnt(0)" ::: "memory")
#define WG_BARRIER() do { asm volatile("s_waitcnt vmcnt(0) lgkmcnt(0)" ::: "memory"); __builtin_amdgcn_s_barrier(); asm volatile("" ::: "memory"); } while (0)

#define XB_TMO      128
#define XB_XCNT(j)  (256  + 64 * (j))
#define XB_XSUB(j)  (1280 + 64 * (j))
#define XB_XGEN(j)  (2304 + 64 * (j))
#define XB_TOP      3328
#define XB_TOPGEN   3392
#define XCD_BAR_WORDS 3456
#define XB_SPIN_CAP (1u << 20)
__device__ __forceinline__ unsigned xb_ld(unsigned* p)              { return __hip_atomic_load(p, __ATOMIC_RELAXED, __HIP_MEMORY_SCOPE_AGENT); }
__device__ __forceinline__ unsigned xb_add(unsigned* p, unsigned v) { return __hip_atomic_fetch_add(p, v, __ATOMIC_RELAXED, __HIP_MEMORY_SCOPE_AGENT); }
__device__ __forceinline__ unsigned xb_xcc_id() { return (unsigned)__builtin_amdgcn_s_getreg((3 << 11) | 20) & 0xFu; }
#define XB_SPIN(cond, bar) do { unsigned _sp = 0; while (cond) { __builtin_amdgcn_s_sleep(1); \
    if ((++_sp & 255u) == 0u) { if (xb_ld(&(bar)[XB_TMO])) break; if (_sp > XB_SPIN_CAP) { atomicAdd(&(bar)[XB_TMO], 1u); break; } } } } while (0)
struct XcdBarrier { unsigned* bar; unsigned x; volatile LAS unsigned* st; };
__device__ __forceinline__ XcdBarrier xcd_barrier_post(unsigned* bar, volatile LAS unsigned* st) {
    XcdBarrier b; b.bar = bar; b.x = xb_xcc_id(); b.st = st;
    if (threadIdx.x == 0) (void)xb_add(&bar[XB_XCNT(b.x)], 1u);
    return b;
}
__device__ __forceinline__ void xcd_barrier_complete(unsigned* bar, unsigned x, unsigned& nloc, unsigned& nx) {
    const unsigned G = gridDim.x * gridDim.y * gridDim.z;
    unsigned sum, cnt, mine, sp = 0u;
    for (;;) {
        sum = 0u; cnt = 0u; mine = 0u;
#pragma unroll
        for (unsigned j = 0; j < 16; ++j) { const unsigned c = xb_ld(&bar[XB_XCNT(j)]); sum += c; cnt += (c > 0u) ? 1u : 0u; mine = (j == x) ? c : mine; }
        if (sum == G) break;
        __builtin_amdgcn_s_sleep(1);
        if ((++sp & 255u) == 0u) { if (xb_ld(&bar[XB_TMO])) break; if (sp > XB_SPIN_CAP) { atomicAdd(&bar[XB_TMO], 1u); break; } }
    }
    nloc = mine > 0u ? mine : 1u; nx = cnt > 0u ? cnt : 1u;
}
__device__ __forceinline__ void xcd_barrier(const XcdBarrier& b) {
    asm volatile("s_waitcnt vmcnt(0)" ::: "memory");
    __syncthreads();
    if (threadIdx.x == 0) {
        unsigned* bar = b.bar;
        __builtin_amdgcn_s_waitcnt(0);
        unsigned nloc = b.st[0], nx = b.st[1];
        if (nloc == 0u) { xcd_barrier_complete(bar, b.x, nloc, nx); b.st[0] = nloc; b.st[1] = nx; }
        const unsigned old = xb_add(&bar[XB_XSUB(b.x)], 1u);
        const unsigned gen = old / nloc;
        if (old + 1u == (gen + 1u) * nloc) {
            __builtin_amdgcn_fence(__ATOMIC_RELEASE, "agent");
            asm volatile("s_waitcnt vmcnt(0)" ::: "memory");
            const unsigned og = xb_add(&bar[XB_TOP], 1u);
            const unsigned tg = og / nx;
            if (og + 1u == (tg + 1u) * nx) xb_add(&bar[XB_TOPGEN], 1u);
            else XB_SPIN(xb_ld(&bar[XB_TOPGEN]) == tg, bar);
            __builtin_amdgcn_fence(__ATOMIC_ACQUIRE, "agent");
            xb_add(&bar[XB_XGEN(b.x)], 1u);
            asm volatile("s_waitcnt vmcnt(0)" ::: "memory");
        } else {
            XB_SPIN(xb_ld(&bar[XB_XGEN(b.x)]) == gen, bar);
            __builtin_amdgcn_fence(__ATOMIC_ACQUIRE, "agent");
            asm volatile("s_waitcnt vmcnt(0)" ::: "memory");
        }
    }
    __syncthreads();
}

__device__ __forceinline__ void glds16_asm(const void* gsrc, unsigned lds_dst) { unsigned keep;
    asm volatile("s_mov_b32 %0, m0\n\ts_mov_b32 m0, %2\n\ts_nop 0\n\tglobal_load_lds_dwordx4 %1, off\n\ts_mov_b32 m0, %0" : "=&s"(keep) : "v"(gsrc), "s"(lds_dst) : "memory"); }
__device__ __forceinline__ void glds16_asm_s(const void* sbase, unsigned voff, unsigned lds_dst) { unsigned keep;
    asm volatile("s_mov_b32 %0, m0\n\ts_mov_b32 m0, %3\n\ts_nop 0\n\tglobal_load_lds_dwordx4 %1, %2\n\ts_mov_b32 m0, %0" : "=&s"(keep) : "v"(voff), "s"(sbase), "s"(lds_dst) : "memory"); }
__device__ __forceinline__ int swz(int row) { return ((row >> 1) & 7) ^ ((row >> 4) & 1); }
constexpr int GK = 1024, GNT = GK / 64;
#ifndef PFON
#define PFON 1
#endif
struct RowLinear { int row0; __device__ __forceinline__ int operator()(int r) const { return row0 + r; } };
struct RowList { const int* list; int n; __device__ __forceinline__ int operator()(int r) const { return r < n ? list[r] : 0; } };

template <int MODE = 0, class RowMap, class Epi>
__device__ __forceinline__ void gemm_tile(LAS unsigned char* lds, const bf16_t* A, const int lda, const RowMap& rm,
                                          const float* Bw, const int ldb, const int bc0, const int bc1, const Epi& epi, const int pf_id = 0) {
    int tid = threadIdx.x; asm volatile("" : "+v"(tid));
    const int lane = tid & 63, wid = __builtin_amdgcn_readfirstlane(tid >> 6);
    const int wr = wid >> 2, wc = wid & 3, fr = lane & 15, fq = lane >> 4;
    unsigned ao[4];
#pragma unroll
    for (int p = 0; p < 4; ++p) { const int r = 32 * wid + 8 * p + (lane >> 3); const int gr = rm(r); const int lc = (lane & 7) ^ swz(r);
        ao[p] = (unsigned)gr * (unsigned)(lda * 2) + (unsigned)(lc * 16); }
    const unsigned bo = (unsigned)((((lane >> 5) ? bc1 : bc0) + 4 * (lane & 31)) * 4);
    const float* bp = Bw + (size_t)(8 * wid) * ldb;
    unsigned bw[4];
#pragma unroll
    for (int c = 0; c < 4; ++c) { const int row = 32 * (lane >> 3) + 16 * (lane & 1) + 4 * ((lane & 7) >> 1) + c; bw[c] = 65536u + (unsigned)(row * 128 + ((wid ^ swz(row)) << 4)); }
    const int sw = (fr >> 1) & 7;
    f32x4 acc[2][2][4][2];
#pragma unroll
    for (int a = 0; a < 2; ++a)
#pragma unroll
        for (int b = 0; b < 2; ++b)
#pragma unroll
            for (int m = 0; m < 4; ++m)
#pragma unroll
                for (int n = 0; n < 2; ++n) acc[a][b][m][n] = (f32x4){0.f, 0.f, 0.f, 0.f};
    f32x4 breg[8];
    unsigned aro = (unsigned)((64 * wr + fr) * 128 + ((fq ^ sw) << 4));
    unsigned bro = 65536u + (unsigned)((32 * wc + fr) * 128 + ((fq ^ sw) << 4));
    const int pf_row = (8 * pf_id + wid) & 63;
    const unsigned lds0 = (unsigned)(uintptr_t)lds;
    unsigned ldsA = (unsigned)(wid * 4096);
#define G_ISSUE_A(T) do { _Pragma("unroll") for (int p = 0; p < 4; ++p) \
        glds16_asm_s((const char*)A + (T) * 128, ao[p], (unsigned)__builtin_amdgcn_readfirstlane((int)(lds0 + ldsA + p * 1024))); } while (0)
#define G_LOAD_B(T) do { _Pragma("unroll") for (int j = 0; j < 8; ++j) asm volatile("global_load_dwordx4 %0, %1, %2" : "=v"(breg[j]) : "v"(bo), "s"(bp + (size_t)((T) * 64 + j) * ldb) : "memory"); } while (0)
#define G_WAIT_B(N) asm volatile("s_waitcnt vmcnt(" #N ")" : "+v"(breg[0]), "+v"(breg[1]), "+v"(breg[2]), "+v"(breg[3]), "+v"(breg[4]), "+v"(breg[5]), "+v"(breg[6]), "+v"(breg[7]) :: "memory")
#define G_WRITE_B() do { _Pragma("unroll") for (int c = 0; c < 4; ++c) { u32x4 w; w.x = pk_bf16(breg[0][c], breg[1][c]); w.y = pk_bf16(breg[2][c], breg[3][c]); \
        w.z = pk_bf16(breg[4][c], breg[5][c]); w.w = pk_bf16(breg[6][c], breg[7][c]); *(LAS u32x4*)(lds + bw[c]) = w; } } while (0)
#define G_COMPUTE() do { _Pragma("unroll") for (int kk = 0; kk < 2; ++kk) { bf16x8 bf[2][2]; \
        _Pragma("unroll") for (int bj = 0; bj < 2; ++bj) _Pragma("unroll") for (int n = 0; n < 2; ++n) bf[bj][n] = *(const LAS bf16x8*)(lds + (bro ^ (kk * 64 + (n & 1) * 16)) + (128 * bj + 16 * n) * 128); \
        _Pragma("unroll") for (int ai = 0; ai < 2; ++ai) { bf16x8 af[4]; \
            _Pragma("unroll") for (int m = 0; m < 4; ++m) af[m] = *(const LAS bf16x8*)(lds + (aro ^ (kk * 64 + (m & 1) * 16)) + (128 * ai + 16 * m) * 128); \
            _Pragma("unroll") for (int bj = 0; bj < 2; ++bj) _Pragma("unroll") for (int m = 0; m < 4; ++m) _Pragma("unroll") for (int n = 0; n < 2; ++n) \
                acc[ai][bj][m][n] = __builtin_amdgcn_mfma_f32_16x16x32_bf16(bf[bj][n], af[m], acc[ai][bj][m][n], 0, 0, 0); \
            __builtin_amdgcn_sched_barrier(0); } } } while (0)
    G_ISSUE_A(0); G_LOAD_B(0); G_WAIT_B(0); G_WRITE_B(); WG_BARRIER();
    if (wr == 0) __builtin_amdgcn_s_setprio(2); else __builtin_amdgcn_s_setprio(0);
#pragma unroll 1
    for (int t = 0; t < GNT; ++t) {
        ldsA ^= 32768u;
#pragma unroll
        for (int c = 0; c < 4; ++c) bw[c] ^= 32768u;
        if (MODE == 0 || MODE == 1) { if (t + 1 < GNT) { G_ISSUE_A(t + 1); G_LOAD_B(t + 1);
            { const int tp = (t + 3 < GNT) ? t + 3 : GNT - 1;
                glds16_asm_s(bp + (ptrdiff_t)(tp * 64 + pf_row - 8 * wid) * ldb, bo, (unsigned)__builtin_amdgcn_readfirstlane((int)(lds0 + 135168u + wid * 1024))); } } }
        __builtin_amdgcn_sched_barrier(0);
        if (MODE != 6) G_COMPUTE();
        if (t + 1 < GNT) { if (MODE == 0 || MODE == 1) G_WAIT_B(1); if (MODE != 7 && MODE != 8) G_WRITE_B(); }
        if (MODE != 8) { asm volatile("s_waitcnt vmcnt(1) lgkmcnt(0)" ::: "memory"); __builtin_amdgcn_s_barrier(); asm volatile("" ::: "memory"); }
        aro ^= 32768u; bro ^= 32768u;
    }
    __builtin_amdgcn_s_setprio(0);
    asm volatile("s_waitcnt vmcnt(0)" ::: "memory");
    if (MODE == 0) epi(acc, wr, wc, fr, fq);
    else { float s_ = 0.f;
#pragma unroll
        for (int a = 0; a < 2; ++a)
#pragma unroll
            for (int b = 0; b < 2; ++b)
#pragma unroll
                for (int m = 0; m < 4; ++m)
#pragma unroll
                    for (int n = 0; n < 2; ++n) s_ += (acc[a][b][m][n][0] + acc[a][b][m][n][1]) + (acc[a][b][m][n][2] + acc[a][b][m][n][3]);
        if (s_ == 12345.678f) *(float*)(const_cast<float*>(Bw)) = s_; }
#undef G_ISSUE_A
#undef G_LOAD_B
#undef G_WRITE_B
#undef G_COMPUTE
}

typedef f32x4 Acc[2][2][4][2];
#define EPI_LOOP_ROWS for (int ai = 0; ai < 2; ++ai) _Pragma("unroll") for (int m = 0; m < 4; ++m)
struct EpiIn { bf16_t* out; int row0, col0; bool act;
    __device__ __forceinline__ void operator()(const Acc& acc, int wr, int wc, int fr, int fq) const {
#pragma unroll
        EPI_LOOP_ROWS { const int row = row0 + 128 * ai + 64 * wr + 16 * m + fr;
#pragma unroll
            for (int bj = 0; bj < 2; ++bj) { f32x4 v0 = acc[ai][bj][m][0], v1 = acc[ai][bj][m][1];
                if (act) {
#pragma unroll
                    for (int r = 0; r < 4; ++r) { v0[r] = gelu_tanh(v0[r]); v1[r] = gelu_tanh(v1[r]); } }
                u32x4 w; w.x = pk_bf16(v0[0], v0[1]); w.y = pk_bf16(v0[2], v0[3]); w.z = pk_bf16(v1[0], v1[1]); w.w = pk_bf16(v1[2], v1[3]);
                *(u32x4*)(out + (size_t)row * INC + col0 + 128 * bj + 32 * wc + 8 * fq) = w; } }
    } };
struct EpiKV { bf16_t* km; bf16_t* vt; int row0, col0;
    __device__ __forceinline__ void operator()(const Acc& acc, int wr, int wc, int fr, int fq) const {
#pragma unroll
        EPI_LOOP_ROWS { const int row = row0 + 128 * ai + 64 * wr + 16 * m + fr;
#pragma unroll
            for (int bj = 0; bj < 2; ++bj) { const f32x4 v0 = acc[ai][bj][m][0], v1 = acc[ai][bj][m][1]; const int col = col0 + 128 * bj + 32 * wc + 8 * fq;
                if (col0 < DM) { u32x4 w; w.x = pk_bf16(v0[0], v0[1]); w.y = pk_bf16(v0[2], v0[3]); w.z = pk_bf16(v1[0], v1[1]); w.w = pk_bf16(v1[2], v1[3]);
                    *(u32x4*)(km + (size_t)row * DM + col) = w; }
                else { const int b = row >> 8, mm = row & 255; bf16_t* base = vt + ((size_t)(b * DM + (col - DM))) * MEML + mm;
#pragma unroll
                    for (int r = 0; r < 4; ++r) { base[(size_t)r * MEML] = (bf16_t)(pk_bf16(v0[r], 0.f) & 0xffffu); base[(size_t)(4 + r) * MEML] = (bf16_t)(pk_bf16(v1[r], 0.f) & 0xffffu); } } } }
    } };
struct EpiResid { const float* xprev; float* out; int row0, col0;
    __device__ __forceinline__ void operator()(const Acc& acc, int wr, int wc, int fr, int fq) const {
#pragma unroll
        EPI_LOOP_ROWS { const int row = row0 + 128 * ai + 64 * wr + 16 * m + fr;
#pragma unroll
            for (int bj = 0; bj < 2; ++bj) { const size_t off = (size_t)row * DM + col0 + 128 * bj + 32 * wc + 8 * fq;
                const f32x4 x0 = *(const f32x4*)(xprev + off), x1 = *(const f32x4*)(xprev + off + 4);
                *(f32x4*)(out + off) = x0 * ALPHA + acc[ai][bj][m][0]; *(f32x4*)(out + off + 4) = x1 * ALPHA + acc[ai][bj][m][1]; } }
    } };
struct EpiBf { bf16_t* out; int row0, col0; float scale;
    __device__ __forceinline__ void operator()(const Acc& acc, int wr, int wc, int fr, int fq) const {
#pragma unroll
        EPI_LOOP_ROWS { const int row = row0 + 128 * ai + 64 * wr + 16 * m + fr;
#pragma unroll
            for (int bj = 0; bj < 2; ++bj) { const f32x4 v0 = acc[ai][bj][m][0] * scale, v1 = acc[ai][bj][m][1] * scale;
                u32x4 w; w.x = pk_bf16(v0[0], v0[1]); w.y = pk_bf16(v0[2], v0[3]); w.z = pk_bf16(v1[0], v1[1]); w.w = pk_bf16(v1[2], v1[3]);
                *(u32x4*)(out + (size_t)row * DM + col0 + 128 * bj + 32 * wc + 8 * fq) = w; } }
    } };
struct EpiSwiglu { bf16_t* out; const float* bgu; int row0, colg;
    __device__ __forceinline__ void operator()(const Acc& acc, int wr, int wc, int fr, int fq) const {
        const int c = colg + 32 * wc + 8 * fq;
        const f32x4 bg0 = *(const f32x4*)(bgu + c), bg1 = *(const f32x4*)(bgu + c + 4), bu0 = *(const f32x4*)(bgu + DM + c), bu1 = *(const f32x4*)(bgu + DM + c + 4);
#pragma unroll
        EPI_LOOP_ROWS { const int row = row0 + 128 * ai + 64 * wr + 16 * m + fr;
            f32x4 o[2];
#pragma unroll
            for (int n = 0; n < 2; ++n) { const f32x4 g4 = acc[ai][0][m][n] + (n ? bg1 : bg0), u4 = acc[ai][1][m][n] + (n ? bu1 : bu0);
#pragma unroll
                for (int r = 0; r < 4; ++r) { const float g = fminf(g4[r], 7.0f), u = fminf(fmaxf(u4[r], -7.0f), 7.0f);
                    const float sg = fast_rcp(1.0f + fast_exp2(-1.702f * 1.4426950408889634f * g));
                    o[n][r] = (u + 1.0f) * (g * sg); } }
            u32x4 w; w.x = pk_bf16(o[0][0], o[0][1]); w.y = pk_bf16(o[0][2], o[0][3]); w.z = pk_bf16(o[1][0], o[1][1]); w.w = pk_bf16(o[1][2], o[1][3]);
            *(u32x4*)(out + (size_t)row * DM + c) = w; }
    } };
struct EpiDown { bf16_t* out; const float* bd; const float* gate; int row0, col0;
    __device__ __forceinline__ void operator()(const Acc& acc, int wr, int wc, int fr, int fq) const {
#pragma unroll
        EPI_LOOP_ROWS { const int tr = 128 * ai + 64 * wr + 16 * m + fr; const float gt = gate[tr];
#pragma unroll
            for (int bj = 0; bj < 2; ++bj) { const int col = col0 + 128 * bj + 32 * wc + 8 * fq;
                const f32x4 v0 = (acc[ai][bj][m][0] + *(const f32x4*)(bd + col)) * gt, v1 = (acc[ai][bj][m][1] + *(const f32x4*)(bd + col + 4)) * gt;
                u32x4 w; w.x = pk_bf16(v0[0], v0[1]); w.y = pk_bf16(v0[2], v0[3]); w.z = pk_bf16(v1[0], v1[1]); w.w = pk_bf16(v1[2], v1[3]);
                *(u32x4*)(out + (size_t)(row0 + tr) * DM + col) = w; } }
    } };

#ifndef PHM
#define PHM 0xFFFF
#endif
#define PH(k) ((PHM >> (k)) & 1)
#ifndef REPM
#define REPM 0x0
#endif
#define PROBE_MODE 8
#define REP(k) for (int rep_ = 0; rep_ < 1 + ((REPM >> (k)) & 1); ++rep_)
struct Params { const float* in[20]; float* out; unsigned char* ws; };

__device__ __forceinline__ void ln_row(const float* src, const float* g, const float* b, float* dst, bf16_t* dstb, int lane) {
    f32x4 v[4]; float s = 0.f;
#pragma unroll
    for (int j = 0; j < 4; ++j) { v[j] = *(const f32x4*)(src + 256 * j + 4 * lane); s += (v[j][0] + v[j][1]) + (v[j][2] + v[j][3]); }
    const float mean = wave_sum(s) * (1.0f / DM); float q = 0.f;
#pragma unroll
    for (int j = 0; j < 4; ++j) { v[j] = v[j] - mean; q += (v[j][0] * v[j][0] + v[j][1] * v[j][1]) + (v[j][2] * v[j][2] + v[j][3] * v[j][3]); }
    const float rstd = 1.0f / sqrtf(wave_sum(q) * (1.0f / DM) + LN_EPS);
#pragma unroll
    for (int j = 0; j < 4; ++j) { const f32x4 gg = *(const f32x4*)(g + 256 * j + 4 * lane), bb = *(const f32x4*)(b + 256 * j + 4 * lane);
        const f32x4 o = v[j] * rstd * gg + bb; *(f32x4*)(dst + 256 * j + 4 * lane) = o;
        u32x2 w; w.x = pk_bf16(o[0], o[1]); w.y = pk_bf16(o[2], o[3]); *(u32x2*)(dstb + 256 * j + 4 * lane) = w; }
}

__global__ void __launch_bounds__(512, 2) mega_fwd(Params P) {
    extern __shared__ __attribute__((aligned(16))) unsigned char lds_raw[];
    LAS unsigned char* lds = (LAS unsigned char*)lds_raw;
#define PHASE_IDS() int tid = threadIdx.x; asm volatile("" : "+v"(tid)); const int lane = tid & 63, wid = __builtin_amdgcn_readfirstlane(tid >> 6); (void)lane; (void)wid
    const int G = gridDim.x, bx = blockIdx.x;
    const int vcu = (G % 8 == 0) ? (bx % 8) * (G / 8) + bx / 8 : bx;
    unsigned char* ws = P.ws;
    unsigned* ctl = (unsigned*)(ws + WS_CTL);
    volatile LAS unsigned* misc = (volatile LAS unsigned*)(lds + LDS_MISC);
    { PHASE_IDS(); if (tid < 64) misc[tid] = 0u; }
    __syncthreads();
    XcdBarrier bar = xcd_barrier_post(ctl + CW_BAR, misc + 8);
#define GRID_BAR() xcd_barrier(bar)

    bf16_t* XB = (bf16_t*)(ws + WS_XB); bf16_t* MEMB = (bf16_t*)(ws + WS_MEMB); bf16_t* PROJ = (bf16_t*)(ws + WS_PROJ);
    bf16_t* KM = (bf16_t*)(ws + WS_KM); bf16_t* VT = (bf16_t*)(ws + WS_VT); bf16_t* YMIX = (bf16_t*)(ws + WS_YMIX);
    float* SBUF = (float*)(ws + WS_SBUF); float* X1 = (float*)(ws + WS_X1); bf16_t* X1B = (bf16_t*)(ws + WS_X1B);
    bf16_t* QM = (bf16_t*)(ws + WS_QM); bf16_t* OM = (bf16_t*)(ws + WS_OM); float* X2 = (float*)(ws + WS_X2); bf16_t* X2B = (bf16_t*)(ws + WS_X2B);
    bf16_t* ABUF = (bf16_t*)(ws + WS_ABUF); bf16_t* YBUF = (bf16_t*)(ws + WS_YBUF); float* X3 = (float*)(ws + WS_X3);

    {
        PHASE_IDS();
        const float* x = P.in[0]; const float* mem = P.in[1];
        const int nthr = G * 512, gt = bx * 512 + tid;
        for (int i = gt; i < NTOK * DM / 4; i += nthr) { const f32x4 v = *(const f32x4*)(x + (size_t)i * 4); u32x2 w; w.x = pk_bf16(v[0], v[1]); w.y = pk_bf16(v[2], v[3]); *(u32x2*)(XB + (size_t)i * 4) = w; }
        for (int i = gt; i < MEMROWS * DM / 4; i += nthr) { const f32x4 v = *(const f32x4*)(mem + (size_t)i * 4); u32x2 w; w.x = pk_bf16(v[0], v[1]); w.y = pk_bf16(v[2], v[3]); *(u32x2*)(MEMB + (size_t)i * 4) = w; }
    }
    GRID_BAR();

#pragma unroll 1
    for (int l = 0; l < DEPTH; ++l) {
        const float* xin = (l == 0) ? P.in[0] : X3;
        float* xout = (l == DEPTH - 1) ? P.out : X3;
        const float* w_in = P.in[2] + (size_t)l * DM * INC;
        const float* sgu_g = P.in[3] + l * 512; const float* sgu_b = P.in[4] + l * 512;
        const float* w_sp = P.in[5] + (size_t)l * 4 * 128 * 128; const float* b_sp = P.in[6] + l * 4 * 128;
        const float* grp_g = P.in[7] + l * DM;
        const float* w_out = P.in[8] + (size_t)l * DM * DM;
        const float* wq = P.in[9] + (size_t)l * DM * DM; const float* wkv = P.in[10] + (size_t)l * DM * 2 * DM; const float* wo = P.in[11] + (size_t)l * DM * DM;
        const float* w_router = P.in[12] + (size_t)l * DM * NE; const float* b_router = P.in[13] + l * NE;
        const float* w_gu = P.in[14] + (size_t)l * NE * DM * 2 * DM; const float* b_gu = P.in[15] + (size_t)l * NE * 2 * DM;
        const float* w_down = P.in[16] + (size_t)l * NE * DM * DM; const float* b_down = P.in[17] + (size_t)l * NE * DM;
        const float* ln_g = P.in[18] + l * 3 * DM; const float* ln_b = P.in[19] + l * 3 * DM;
        unsigned* cnt = ctl + CW_CNT + l * 64;
        int* list_tok = (int*)(ws + WS_ROUTE + l * ROUTE_LAYER); float* list_gate = (float*)(ws + WS_ROUTE + l * ROUTE_LAYER + 2 * MiB); int* sel = (int*)(ws + WS_ROUTE + l * ROUTE_LAYER + 4 * MiB);

        if (PH(1)) REP(1)
#pragma unroll 1
        for (int u = vcu; u < 704; u += G) {
            if (u < 640) { const int ct = u >> 6, rt = u & 63;
                EpiIn E{PROJ, 256 * rt, 256 * ct, ct < 4}; RowLinear rm{256 * rt};
                gemm_tile(lds, XB, DM, rm, w_in, INC, 256 * ct, 256 * ct + 128, E, rt & 7);
            } else { const int v = u - 640, ct = v >> 3, rt = v & 7;
                EpiKV E{KM, VT, 256 * rt, 256 * ct}; RowLinear rm{256 * rt};
                gemm_tile(lds, MEMB, DM, rm, wkv, 2 * DM, 256 * ct, 256 * ct + 128, E, rt & 7);
            }
        }
        GRID_BAR();

        if (PH(2)) REP(2)
        {
            PHASE_IDS();
#pragma unroll 1
            for (int u = vcu; u < 512; u += G) {
                const int g = u & 3, c = (u >> 2) & 15, b = u >> 6; const int tok0 = b * SEQ + 128 * c;
                {
                    const int tp = tid >> 3, cg = tid & 7;
                    float vv[2][16];
#pragma unroll
                    for (int s = 0; s < 2; ++s) { const bf16_t* src = PROJ + (size_t)(tok0 + 2 * tp + s) * INC + 512 + 128 * g + 16 * cg;
                        const u32x4 a = *(const u32x4*)src, bq = *(const u32x4*)(src + 8);
#pragma unroll
                        for (int e = 0; e < 4; ++e) { vv[s][2 * e] = bf2f(a[e] & 0xffffu); vv[s][2 * e + 1] = bf2f(a[e] >> 16); vv[s][8 + 2 * e] = bf2f(bq[e] & 0xffffu); vv[s][8 + 2 * e + 1] = bf2f(bq[e] >> 16); }
                        float sm = 0.f;
#pragma unroll
                        for (int e = 0; e < 16; ++e) sm += vv[s][e];
                        sm += __shfl_xor(sm, 1); sm += __shfl_xor(sm, 2); sm += __shfl_xor(sm, 4);
                        const float mean = sm * (1.0f / 128.0f); float q = 0.f;
#pragma unroll
                        for (int e = 0; e < 16; ++e) { vv[s][e] -= mean; q += vv[s][e] * vv[s][e]; }
                        q += __shfl_xor(q, 1); q += __shfl_xor(q, 2); q += __shfl_xor(q, 4);
                        const float rstd = 1.0f / sqrtf(q * (1.0f / 128.0f) + LN_EPS);
#pragma unroll
                        for (int e = 0; e < 16; ++e) vv[s][e] = vv[s][e] * rstd * sgu_g[128 * g + 16 * cg + e] + sgu_b[128 * g + 16 * cg + e];
                    }
                    const int s0 = 2 * tp, chunk = s0 >> 3;
#pragma unroll
                    for (int e = 0; e < 16; ++e) { const int d = 16 * cg + e;
                        *(LAS unsigned*)(lds + d * 256 + ((chunk ^ (d & 15)) << 4) + (s0 & 7) * 2) = pk_bf16(vv[0][e], vv[1][e]); }
                }
                WG_BARRIER();
                {
                    const int fr = lane & 15, fq = lane >> 4, t = 16 * wid + fr;
                    f32x4 acc[8];
#pragma unroll
                    for (int nb = 0; nb < 8; ++nb) acc[nb] = (f32x4){0.f, 0.f, 0.f, 0.f};
                    const float* wrow = w_sp + ((size_t)g * 128 + t) * 128;
                    const int nkk = (wid >> 1) + 1;
#pragma unroll 1
                    for (int kk = 0; kk < nkk; ++kk) {
                        const int sb = 32 * kk + 8 * fq;
                        const f32x4 w0 = *(const f32x4*)(wrow + sb), w1 = *(const f32x4*)(wrow + sb + 4);
                        float wv[8] = {w0[0], w0[1], w0[2], w0[3], w1[0], w1[1], w1[2], w1[3]};
#pragma unroll
                        for (int j = 0; j < 8; ++j) wv[j] = (sb + j <= t) ? wv[j] : 0.f;
                        u32x4 wp; wp.x = pk_bf16(wv[0], wv[1]); wp.y = pk_bf16(wv[2], wv[3]); wp.z = pk_bf16(wv[4], wv[5]); wp.w = pk_bf16(wv[6], wv[7]);
                        const bf16x8 wf = __builtin_bit_cast(bf16x8, wp);
#pragma unroll
                        for (int nb = 0; nb < 8; ++nb) { const int d = 16 * nb + fr;
                            const bf16x8 vf = *(const LAS bf16x8*)(lds + d * 256 + ((((4 * kk + fq) ^ (d & 15))) << 4));
                            acc[nb] = __builtin_amdgcn_mfma_f32_16x16x32_bf16(vf, wf, acc[nb], 0, 0, 0); }
                    }
                    const float bias = b_sp[g * 128 + t];
                    const bf16_t* urow = PROJ + (size_t)(tok0 + t) * INC + 128 * g;
                    float ms = 0.f;
#pragma unroll
                    for (int nb = 0; nb < 8; ++nb) { const u32x2 uu = *(const u32x2*)(urow + 16 * nb + 4 * fq);
                        const float u0 = bf2f(uu.x & 0xffffu), u1 = bf2f(uu.x >> 16), u2 = bf2f(uu.y & 0xffffu), u3 = bf2f(uu.y >> 16);
                        acc[nb][0] = u0 * (acc[nb][0] + bias); acc[nb][1] = u1 * (acc[nb][1] + bias); acc[nb][2] = u2 * (acc[nb][2] + bias); acc[nb][3] = u3 * (acc[nb][3] + bias);
                        ms += (acc[nb][0] * acc[nb][0] + acc[nb][1] * acc[nb][1]) + (acc[nb][2] * acc[nb][2] + acc[nb][3] * acc[nb][3]); }
                    ms += __shfl_xor(ms, 16); ms += __shfl_xor(ms, 32);
                    const float sc = 1.0f / sqrtf(ms * (1.0f / 128.0f) + RMS_EPS);
                    bf16_t* yrow = YMIX + (size_t)(tok0 + t) * DM + 128 * g;
#pragma unroll
                    for (int nb = 0; nb < 8; ++nb) { const f32x4 gg = *(const f32x4*)(grp_g + 128 * g + 16 * nb + 4 * fq); const f32x4 o = acc[nb] * sc * gg;
                        u32x2 w; w.x = pk_bf16(o[0], o[1]); w.y = pk_bf16(o[2], o[3]); *(u32x2*)(yrow + 16 * nb + 4 * fq) = w; }
                }
                WG_BARRIER();
            }
#pragma unroll 1
            for (int pp = 2 * vcu; pp < 1024; pp = ((pp & 1) ? pp + 2 * G - 1 : pp + 1)) {
                const int pr = pp >> 1, bh = pr >> 3, ip = pr & 7, qi = (pp & 1) ? (15 - ip) : ip;
                const int b = bh >> 3, h = bh & 7; const int tokb = b * SEQ;
                const int fr = lane & 15, fq = lane >> 4, tq = 128 * qi + 16 * wid + fr;
                bf16x8 qf[2];
#pragma unroll
                for (int kk = 0; kk < 2; ++kk) qf[kk] = *(const bf16x8*)(PROJ + (size_t)(tokb + tq) * INC + 1024 + 64 * h + 32 * kk + 8 * fq);
                f32x4 oacc[4];
#pragma unroll
                for (int db = 0; db < 4; ++db) oacc[db] = (f32x4){0.f, 0.f, 0.f, 0.f};
                float R = 0.f;
                const int ntile = 2 * qi + 2;
#pragma unroll 1
                for (int jt = ntile - 1; jt >= 0; --jt) {
                    LAS unsigned char* vbuf = lds + (jt & 1) * 8704;
                    {
                        const int kv = tid >> 3, ch = tid & 7;
                        const u32x4 a = *(const u32x4*)(PROJ + (size_t)(tokb + 64 * jt + kv) * INC + 2048 + 64 * h + 8 * ch);
#pragma unroll
                        for (int e = 0; e < 4; ++e) { *(LAS bf16_t*)(vbuf + (8 * ch + 2 * e) * 136 + 2 * kv) = (bf16_t)(a[e] & 0xffffu); *(LAS bf16_t*)(vbuf + (8 * ch + 2 * e + 1) * 136 + 2 * kv) = (bf16_t)(a[e] >> 16); }
                    }
                    WG_BARRIER();
                    if (64 * jt < 128 * qi + 16 * wid + 15) {
                        f32x4 z[4];
#pragma unroll
                        for (int nb = 0; nb < 4; ++nb) { z[nb] = (f32x4){0.f, 0.f, 0.f, 0.f};
#pragma unroll
                            for (int kk = 0; kk < 2; ++kk) { const bf16x8 kf = *(const bf16x8*)(PROJ + (size_t)(tokb + 64 * jt + 16 * nb + fr) * INC + 1536 + 64 * h + 32 * kk + 8 * fq);
                                z[nb] = __builtin_amdgcn_mfma_f32_16x16x32_bf16(kf, qf[kk], z[nb], 0, 0, 0); } }
                        float lnot[4][4], lsig[4][4], gsum[4];
#pragma unroll
                        for (int nb = 0; nb < 4; ++nb) { gsum[nb] = 0.f;
#pragma unroll
                            for (int r = 0; r < 4; ++r) { const float zz = z[nb][r] * 0.125f; const int s = 64 * jt + 16 * nb + 4 * fq + r;
                                const float sp = fmaxf(zz, 0.f) + 0.6931471805599453f * fast_log2(1.0f + fast_exp2(-1.4426950408889634f * fabsf(zz)));
                                const bool valid = s < tq;
                                lnot[nb][r] = valid ? -sp : 0.f; lsig[nb][r] = valid ? (zz - sp) : -1.0e30f; gsum[nb] += lnot[nb][r]; } }
                        float off = R;
                        u32x4 pw[2];
#pragma unroll
                        for (int nb = 3; nb >= 0; --nb) {
                            const float x1 = __shfl_xor(gsum[nb], 16), x2 = __shfl_xor(gsum[nb], 32), x3 = __shfl_xor(gsum[nb], 48);
                            const float tot = (gsum[nb] + x1) + (x2 + x3);
                            const float suf = ((fq & 1) ? 0.f : x1) + ((fq & 2) ? 0.f : (x2 + x3));
                            float c3 = off + suf, c2 = c3 + lnot[nb][3], c1 = c2 + lnot[nb][2], c0 = c1 + lnot[nb][1];
                            const float p0 = fast_exp2(1.4426950408889634f * (lsig[nb][0] + c0)), p1 = fast_exp2(1.4426950408889634f * (lsig[nb][1] + c1));
                            const float p2 = fast_exp2(1.4426950408889634f * (lsig[nb][2] + c2)), p3 = fast_exp2(1.4426950408889634f * (lsig[nb][3] + c3));
                            const unsigned lo = pk_bf16(p0, p1), hi = pk_bf16(p2, p3);
                            if (nb == 0) { pw[0].x = lo; pw[0].y = hi; } else if (nb == 1) { pw[0].z = lo; pw[0].w = hi; } else if (nb == 2) { pw[1].x = lo; pw[1].y = hi; } else { pw[1].z = lo; pw[1].w = hi; }
                            off += tot;
                        }
                        R = off;
#pragma unroll
                        for (int kk = 0; kk < 2; ++kk) { const bf16x8 pf = __builtin_bit_cast(bf16x8, pw[kk]);
#pragma unroll
                            for (int db = 0; db < 4; ++db) { const LAS unsigned char* vp = vbuf + (16 * db + fr) * 136 + (32 * kk + 4 * fq) * 2;
                                const u32x2 v0 = *(const LAS u32x2*)vp, v1 = *(const LAS u32x2*)(vp + 32);
                                u32x4 vv; vv.x = v0.x; vv.y = v0.y; vv.z = v1.x; vv.w = v1.y;
                                oacc[db] = __builtin_amdgcn_mfma_f32_16x16x32_bf16(__builtin_bit_cast(bf16x8, vv), pf, oacc[db], 0, 0, 0); } }
                    }
                }
                float ms = 0.f;
#pragma unroll
                for (int db = 0; db < 4; ++db) ms += (oacc[db][0] * oacc[db][0] + oacc[db][1] * oacc[db][1]) + (oacc[db][2] * oacc[db][2] + oacc[db][3] * oacc[db][3]);
                ms += __shfl_xor(ms, 16); ms += __shfl_xor(ms, 32);
                const float sc = 1.0f / sqrtf(ms * (1.0f / 64.0f) + RMS_EPS);
                bf16_t* yrow = YMIX + (size_t)(tokb + tq) * DM + 512 + 64 * h;
#pragma unroll
                for (int db = 0; db < 4; ++db) { const f32x4 gg = *(const f32x4*)(grp_g + 512 + 64 * h + 16 * db + 4 * fq); const f32x4 o = oacc[db] * sc * gg;
                    u32x2 w; w.x = pk_bf16(o[0], o[1]); w.y = pk_bf16(o[2], o[3]); *(u32x2*)(yrow + 16 * db + 4 * fq) = w; }
                WG_BARRIER();
            }
        }
        GRID_BAR();

        if (PH(3)) REP(3)
#pragma unroll 1
        for (int u = vcu; u < 256; u += G) { const int ct = u >> 6, rt = u & 63;
            EpiResid E{xin, SBUF, 256 * rt, 256 * ct}; RowLinear rm{256 * rt};
            gemm_tile(lds, YMIX, DM, rm, w_out, DM, 256 * ct, 256 * ct + 128, E, rt & 7); }
        GRID_BAR();
        if (PH(4)) REP(4)
        { PHASE_IDS();
#pragma unroll 1
        for (int row = vcu * 8 + wid; row < NTOK; row += G * 8) ln_row(SBUF + (size_t)row * DM, ln_g, ln_b, X1 + (size_t)row * DM, X1B + (size_t)row * DM, lane); }
        GRID_BAR();
        if (PH(5)) REP(5)
#pragma unroll 1
        for (int u = vcu; u < 256; u += G) { const int ct = u >> 6, rt = u & 63;
            EpiBf E{QM, 256 * rt, 256 * ct, 0.0625f}; RowLinear rm{256 * rt};
            gemm_tile(lds, X1B, DM, rm, wq, DM, 256 * ct, 256 * ct + 128, E, rt & 7); }
        GRID_BAR();
        if (PH(6)) REP(6)
#pragma unroll 1
        for (int u = vcu; u < 512; u += G) {
            PHASE_IDS();
            const int qb = u & 15, h = (u >> 4) & 3, b = u >> 6;
            const int fr = lane & 15, fq = lane >> 4, tq = b * SEQ + 128 * qb + 16 * wid + fr;
            f32x4 sacc[16];
            {
                bf16x8 qf[8];
#pragma unroll
                for (int kk = 0; kk < 8; ++kk) qf[kk] = *(const bf16x8*)(QM + (size_t)tq * DM + 256 * h + 32 * kk + 8 * fq);
#pragma unroll
                for (int mb = 0; mb < 16; ++mb) { sacc[mb] = (f32x4){0.f, 0.f, 0.f, 0.f};
                    const bf16_t* krow = KM + (size_t)(b * MEML + 16 * mb + fr) * DM + 256 * h + 8 * fq;
#pragma unroll
                    for (int kk = 0; kk < 8; ++kk) { const bf16x8 kf = *(const bf16x8*)(krow + 32 * kk); sacc[mb] = __builtin_amdgcn_mfma_f32_16x16x32_bf16(kf, qf[kk], sacc[mb], 0, 0, 0); } }
            }
            float mx = -3.0e38f;
#pragma unroll
            for (int mb = 0; mb < 16; ++mb) mx = fmaxf(mx, fmaxf(fmaxf(sacc[mb][0], sacc[mb][1]), fmaxf(sacc[mb][2], sacc[mb][3])));
            mx = fmaxf(mx, __shfl_xor(mx, 16)); mx = fmaxf(mx, __shfl_xor(mx, 32));
            float den = 0.f; u32x4 pw[8];
#pragma unroll
            for (int mb = 0; mb < 16; ++mb) {
                const float p0 = fast_exp2(1.4426950408889634f * (sacc[mb][0] - mx)), p1 = fast_exp2(1.4426950408889634f * (sacc[mb][1] - mx));
                const float p2 = fast_exp2(1.4426950408889634f * (sacc[mb][2] - mx)), p3 = fast_exp2(1.4426950408889634f * (sacc[mb][3] - mx));
                den += (p0 + p1) + (p2 + p3);
                const unsigned lo = pk_bf16(p0, p1), hi = pk_bf16(p2, p3);
                if (mb & 1) { pw[mb >> 1].z = lo; pw[mb >> 1].w = hi; } else { pw[mb >> 1].x = lo; pw[mb >> 1].y = hi; }
            }
            den += __shfl_xor(den, 16); den += __shfl_xor(den, 32);
            const float rden = 1.0f / den;
            bf16_t* orow = OM + (size_t)tq * DM + 256 * h;
#pragma unroll 2
            for (int db = 0; db < 16; ++db) {
                f32x4 o = (f32x4){0.f, 0.f, 0.f, 0.f};
                const bf16_t* vrow = VT + ((size_t)(b * DM + 256 * h + 16 * db + fr)) * MEML + 4 * fq;
#pragma unroll
                for (int kk = 0; kk < 8; ++kk) { const u32x2 v0 = *(const u32x2*)(vrow + 32 * kk), v1 = *(const u32x2*)(vrow + 32 * kk + 16);
                    u32x4 vv; vv.x = v0.x; vv.y = v0.y; vv.z = v1.x; vv.w = v1.y;
                    o = __builtin_amdgcn_mfma_f32_16x16x32_bf16(__builtin_bit_cast(bf16x8, vv), __builtin_bit_cast(bf16x8, pw[kk]), o, 0, 0, 0); }
                o = o * rden;
                u32x2 w; w.x = pk_bf16(o[0], o[1]); w.y = pk_bf16(o[2], o[3]); *(u32x2*)(orow + 16 * db + 4 * fq) = w;
            }
        }
        GRID_BAR();
        if (PH(7)) REP(7)
#pragma unroll 1
        for (int u = vcu; u < 256; u += G) { const int ct = u >> 6, rt = u & 63;
            EpiResid E{X1, SBUF, 256 * rt, 256 * ct}; RowLinear rm{256 * rt};
            gemm_tile(lds, OM, DM, rm, wo, DM, 256 * ct, 256 * ct + 128, E, rt & 7); }
        GRID_BAR();
        if (PH(8)) REP(8)
#pragma unroll 1
        for (int ch = vcu; ch < NTOK / 64; ch += G) {
            PHASE_IDS();
            const int r0 = ch * 64;
#pragma unroll 1
            for (int i = 0; i < 8; ++i) { const int row = r0 + 8 * wid + i; ln_row(SBUF + (size_t)row * DM, ln_g + DM, ln_b + DM, X2 + (size_t)row * DM, X2B + (size_t)row * DM, lane); }
            WG_BARRIER();
            {
                const int fr = lane & 15, fq = lane >> 4, tg = wid & 3, kh = wid >> 2, t0 = r0 + 16 * tg;
                unsigned* cntp = rep_ ? cnt + 32 : cnt; int* ltok = rep_ ? (int*)ABUF : list_tok; float* lgate = rep_ ? (float*)ABUF + 4 * MiB : list_gate; int* selp = rep_ ? (int*)ABUF + 8 * MiB : sel;
                LAS unsigned* lcnt = (LAS unsigned*)(lds + LDS_TAB + 1024); LAS unsigned* lbase = lcnt + 32;
                if (tid < 32) lcnt[tid] = 0u;
                f32x4 a0 = (f32x4){0.f, 0.f, 0.f, 0.f}, a1 = (f32x4){0.f, 0.f, 0.f, 0.f};
                const float* xr = X2 + (size_t)(t0 + fr) * DM + 512 * kh + 4 * fq;
                const float* wr0 = w_router + (size_t)(512 * kh + 4 * fq) * NE + fr;
#pragma unroll 4
                for (int kb = 0; kb < 32; ++kb) {
                    const f32x4 xa = *(const f32x4*)(xr + 16 * kb);
                    const float* wrp = wr0 + (size_t)(16 * kb) * NE;
                    float wv0[4], wv1[4];
#pragma unroll
                    for (int c = 0; c < 4; ++c) { wv0[c] = wrp[c * NE]; wv1[c] = wrp[c * NE + 16]; }
#pragma unroll
                    for (int c = 0; c < 4; ++c) { a0 = __builtin_amdgcn_mfma_f32_16x16x4f32(xa[c], wv0[c], a0, 0, 0, 0); a1 = __builtin_amdgcn_mfma_f32_16x16x4f32(xa[c], wv1[c], a1, 0, 0, 0); }
                }
                LAS f32x4* px = (LAS f32x4*)lds;
                if (kh == 1) { px[(tg * 64 + lane) * 2] = a0; px[(tg * 64 + lane) * 2 + 1] = a1; }
                WG_BARRIER();
                float mye[4]; int myi[4]; unsigned lpos[4];
                if (kh == 0) {
                    a0 = a0 + px[(tg * 64 + lane) * 2]; a1 = a1 + px[(tg * 64 + lane) * 2 + 1];
                    const float br0 = b_router[fr], br1 = b_router[16 + fr];
#pragma unroll
                    for (int r = 0; r < 4; ++r) { float v0 = a0[r] + br0, v1 = a1[r] + br1; float sv[4]; int si[4];
#pragma unroll
                        for (int kq = 0; kq < 4; ++kq) { float bv = (v0 >= v1) ? v0 : v1; int bi = (v0 >= v1) ? fr : 16 + fr;
#pragma unroll
                            for (int o = 1; o < 16; o <<= 1) { const float ov = __shfl_xor(bv, o); const int oi = __shfl_xor(bi, o); const bool take = (ov > bv) || (ov == bv && oi < bi); bv = take ? ov : bv; bi = take ? oi : bi; }
                            sv[kq] = bv; si[kq] = bi; if (bi == fr) v0 = -3.0e38f; if (bi == 16 + fr) v1 = -3.0e38f; }
                        const float e1 = fast_exp2(1.4426950408889634f * (sv[1] - sv[0])), e2 = fast_exp2(1.4426950408889634f * (sv[2] - sv[0])), e3 = fast_exp2(1.4426950408889634f * (sv[3] - sv[0]));
                        const float inv = 1.0f / (((1.0f + e1) + e2) + e3);
                        mye[r] = ((fr == 0) ? 1.0f : (fr == 1) ? e1 : (fr == 2) ? e2 : e3) * inv;
                        myi[r] = (fr == 0) ? si[0] : (fr == 1) ? si[1] : (fr == 2) ? si[2] : si[3];
                        lpos[r] = 0u;
                        if (fr < 4) lpos[r] = atomicAdd((unsigned*)(lcnt + myi[r]), 1u);
                    }
                }
                WG_BARRIER();
                if (tid < 32) lbase[tid] = atomicAdd(cntp + tid, lcnt[tid]);
                WG_BARRIER();
                if (kh == 0 && fr < 4) {
#pragma unroll
                    for (int r = 0; r < 4; ++r) { const int tok = t0 + 4 * fq + r; const unsigned pos = lbase[myi[r]] + lpos[r];
                        ltok[(size_t)myi[r] * NTOK + pos] = tok; lgate[(size_t)myi[r] * NTOK + pos] = mye[r]; selp[tok * 4 + fr] = myi[r] * NTOK + (int)pos; }
                }
            }
            WG_BARRIER();
        }
        GRID_BAR();
        LAS int* tab = (LAS int*)(lds + LDS_TAB);
        if (threadIdx.x == 0) { int rb = 0, tp = 0;
            for (int e = 0; e < NE; ++e) { const int c = (int)xb_ld(cnt + e); const int nt = (c + 255) >> 8; tab[e] = c; tab[32 + e] = nt; tab[64 + e] = rb; tab[96 + e] = tp; rb += nt * 256; tp += nt; }
            tab[96 + NE] = tp; }
        WG_BARRIER();
        const int ntile_tot = tab[96 + NE];
        if (PH(9)) REP(9)
#pragma unroll 1
        for (int u = vcu; u < ntile_tot * 8; u += G) {
            int e = 0;
#pragma unroll 1
            for (int q = 1; q < NE; ++q) if (u >= tab[96 + q] * 8) e = q;
            const int v = u - tab[96 + e] * 8, nt = tab[32 + e], ct = v / nt, rt = v - ct * nt;
            RowList rm{list_tok + (size_t)e * NTOK + 256 * rt, tab[e] - 256 * rt};
            EpiSwiglu E{ABUF, b_gu + (size_t)e * 2 * DM, tab[64 + e] + 256 * rt, 128 * ct};
            if (rep_ == 0) gemm_tile<0>(lds, X2B, DM, rm, w_gu + (size_t)e * DM * 2 * DM, 2 * DM, 128 * ct, DM + 128 * ct, E, rt);
            else gemm_tile<PROBE_MODE>(lds, X2B, DM, rm, w_gu + (size_t)e * DM * 2 * DM, 2 * DM, 128 * ct, DM + 128 * ct, E, rt);
        }
        GRID_BAR();
        if (PH(10)) REP(10)
#pragma unroll 1
        for (int u = vcu; u < ntile_tot * 4; u += G) {
            int e = 0;
#pragma unroll 1
            for (int q = 1; q < NE; ++q) if (u >= tab[96 + q] * 4) e = q;
            const int v = u - tab[96 + e] * 4, nt = tab[32 + e], ct = v / nt, rt = v - ct * nt;
            RowLinear rm{tab[64 + e] + 256 * rt};
            EpiDown E{YBUF, b_down + (size_t)e * DM, list_gate + (size_t)e * NTOK + 256 * rt, tab[64 + e] + 256 * rt, 256 * ct};
            gemm_tile(lds, ABUF, DM, rm, w_down + (size_t)e * DM * DM, DM, 256 * ct, 256 * ct + 128, E, rt);
        }
        GRID_BAR();
        if (PH(11)) REP(11)
#pragma unroll 1
        for (int row = vcu * 8 + (int)(threadIdx.x >> 6); row < NTOK; row += G * 8) {
            PHASE_IDS();
            int rows[4];
#pragma unroll
            for (int k = 0; k < 4; ++k) { const int s = sel[row * 4 + k]; const int e = s >> 14, pos = s & (NTOK - 1); rows[k] = tab[64 + e] + pos; }
            f32x4 v[4]; float sm = 0.f;
#pragma unroll
            for (int j = 0; j < 4; ++j) { v[j] = *(const f32x4*)(X2 + (size_t)row * DM + 256 * j + 4 * lane) * ALPHA;
#pragma unroll
                for (int k = 0; k < 4; ++k) { const u32x2 y = *(const u32x2*)(YBUF + (size_t)rows[k] * DM + 256 * j + 4 * lane);
                    v[j][0] += bf2f(y.x & 0xffffu); v[j][1] += bf2f(y.x >> 16); v[j][2] += bf2f(y.y & 0xffffu); v[j][3] += bf2f(y.y >> 16); }
                sm += (v[j][0] + v[j][1]) + (v[j][2] + v[j][3]); }
            const float mean = wave_sum(sm) * (1.0f / DM); float q = 0.f;
#pragma unroll
            for (int j = 0; j < 4; ++j) { v[j] = v[j] - mean; q += (v[j][0] * v[j][0] + v[j][1] * v[j][1]) + (v[j][2] * v[j][2] + v[j][3] * v[j][3]); }
            const float rstd = 1.0f / sqrtf(wave_sum(q) * (1.0f / DM) + LN_EPS);
#pragma unroll
            for (int j = 0; j < 4; ++j) { const f32x4 gg = *(const f32x4*)(ln_g + 2 * DM + 256 * j + 4 * lane), bb = *(const f32x4*)(ln_b + 2 * DM + 256 * j + 4 * lane);
                const f32x4 o = v[j] * rstd * gg + bb; *(f32x4*)(xout + (size_t)row * DM + 256 * j + 4 * lane) = o;
                u32x2 w; w.x = pk_bf16(o[0], o[1]); w.y = pk_bf16(o[2], o[3]); *(u32x2*)(XB + (size_t)row * DM + 256 * j + 4 * lane) = w; }
        }
        if (l + 1 < DEPTH) GRID_BAR();
    }
}

extern "C" void kernel_launch(void* const* d_in, const int* in_sizes, int n_in, void* d_out, int out_size, void* d_ws, size_t ws_size, hipStream_t stream) {
    static int grid = 0;
    if (grid == 0) {
        if (n_in != 20 || out_size != NTOK * DM || ws_size < WS_END) { fprintf(stderr, "kernel_launch: unexpected shapes (n_in %d, out %d, ws %zu)\n", n_in, out_size, ws_size); grid = -1; return; }
        int dev = 0, cus = 0;
        if (hipGetDevice(&dev) != hipSuccess || hipDeviceGetAttribute(&cus, hipDeviceAttributeMultiprocessorCount, dev) != hipSuccess) { grid = -1; return; }
        if (hipFuncSetAttribute((const void*)mega_fwd, hipFuncAttributeMaxDynamicSharedMemorySize, LDS_BYTES) != hipSuccess) { fprintf(stderr, "kernel_launch: hipFuncSetAttribute failed\n"); grid = -1; return; }
        (void)hipGetLastError();
        grid = cus;
    }
    if (grid < 0) return;
    (void)hipMemsetAsync((char*)d_ws + WS_CTL, 0, CTL_BYTES, stream);
    Params p{};
    for (int i = 0; i < 20; ++i) p.in[i] = (const float*)d_in[i];
    p.out = (float*)d_out; p.ws = (unsigned char*)d_ws;
    hipLaunchKernelGGL(mega_fwd, dim3(grid), dim3(512), LDS_BYTES, stream, p);
}
```

```cpp
#include <hip/hip_runtime.h>
#include <cstdio>
#include <cstdint>

#define LAS __attribute__((address_space(3)))
typedef unsigned short bf16_t;
typedef short bf16x8 __attribute__((ext_vector_type(8)));
typedef short s16x4 __attribute__((ext_vector_type(4)));
typedef float f32x4 __attribute__((ext_vector_type(4)));
typedef float f32x2 __attribute__((ext_vector_type(2)));
typedef unsigned u32x4 __attribute__((ext_vector_type(4)));
typedef unsigned u32x2 __attribute__((ext_vector_type(2)));
typedef __bf16 bf16x2_t __attribute__((ext_vector_type(2)));

constexpr int NB = 8, SEQ = 2048, DM = 1024, NTOK = NB * SEQ, DEPTH = 2;
constexpr int INC = 2560;
constexpr int MEML = 256, MEMROWS = NB * MEML;
constexpr int NE = 32, TOPK = 4;
constexpr int PROWS = NTOK * TOPK + NE * 256;
constexpr float ALPHA = 1.4142135623730951f;
constexpr float LN_EPS = 1e-5f, RMS_EPS = 1e-6f;

constexpr size_t MiB = 1u << 20;
constexpr size_t WS_CTL = 0, CTL_BYTES = 1 * MiB;
constexpr size_t WS_XB = 1 * MiB;
constexpr size_t WS_MEMB = 33 * MiB;
constexpr size_t WS_PROJ = 37 * MiB;
constexpr size_t WS_KM = 117 * MiB;
constexpr size_t WS_VT = 121 * MiB;
constexpr size_t WS_YMIX = 125 * MiB;
constexpr size_t WS_SBUF = 157 * MiB;
constexpr size_t WS_X1 = 221 * MiB;
constexpr size_t WS_X1B = 285 * MiB;
constexpr size_t WS_QM = 317 * MiB;
constexpr size_t WS_OM = 349 * MiB;
constexpr size_t WS_X2 = 381 * MiB;
constexpr size_t WS_X2B = 445 * MiB;
constexpr size_t WS_ROUTE = 477 * MiB;
constexpr size_t ROUTE_LAYER = 5 * MiB;
constexpr size_t WS_ABUF = 487 * MiB;
constexpr size_t WS_YBUF = 631 * MiB;
constexpr size_t WS_X3 = 775 * MiB;
constexpr size_t WS_END = 839 * MiB;
constexpr int CW_BAR = 4096;
constexpr int CW_CNT = 8192;

constexpr int LDS_TAB = 131072;
constexpr int LDS_MISC = 131072 + 2048;
constexpr int LDS_BYTES = 147456;

__device__ __forceinline__ float bf2f(unsigned h) { return __uint_as_float(h << 16); }
__device__ __forceinline__ unsigned pk_bf16(float lo, float hi) { f32x2 v = {lo, hi}; bf16x2_t b = __builtin_convertvector(v, bf16x2_t); return __builtin_bit_cast(unsigned, b); }
__device__ __forceinline__ float fast_exp2(float x) { return __builtin_amdgcn_exp2f(x); }
__device__ __forceinline__ float fast_log2(float x) { return __builtin_amdgcn_logf(x); }
__device__ __forceinline__ float fast_rcp(float x) { return __builtin_amdgcn_rcpf(x); }
__device__ __forceinline__ float fast_rsq(float x) { return __builtin_amdgcn_rsqf(x); }
__device__ __forceinline__ float gelu_tanh(float x) {
    const float y = 1.5957691216057308f * x * (1.0f + 0.044715f * x * x);
    return x * fast_rcp(1.0f + fast_exp2(-1.4426950408889634f * y));
}
__device__ __forceinline__ float wave_sum(float v) {
#pragma unroll
    for (int o = 1; o < 64; o <<= 1) v += __shfl_xor(v, o);
    return v;
}
#define VM_WAIT() asm volatile("s_waitcnt vmcnt(0)" ::: "memory")
#define WG_BARRIER() do { asm volatile("s_waitcnt vmcnt(0) lgkmcnt(0)" ::: "memory"); __builtin_amdgcn_s_barrier(); asm volatile("" ::: "memory"); } while (0)

#define XB_TMO      128
#define XB_XCNT(j)  (256  + 64 * (j))
#define XB_XSUB(j)  (1280 + 64 * (j))
#define XB_XGEN(j)  (2304 + 64 * (j))
#define XB_TOP      3328
#define XB_TOPGEN   3392
#define XCD_BAR_WORDS 3456
#define XB_SPIN_CAP (1u << 20)
__device__ __forceinline__ unsigned xb_ld(unsigned* p)              { return __hip_atomic_load(p, __ATOMIC_RELAXED, __HIP_MEMORY_SCOPE_AGENT); }
__device__ __forceinline__ unsigned xb_add(unsigned* p, unsigned v) { return __hip_atomic_fetch_add(p, v, __ATOMIC_RELAXED, __HIP_MEMORY_SCOPE_AGENT); }
__device__ __forceinline__ unsigned xb_xcc_id() { return (unsigned)__builtin_amdgcn_s_getreg((3 << 11) | 20) & 0xFu; }
#define XB_SPIN(cond, bar) do { unsigned _sp = 0; while (cond) { __builtin_amdgcn_s_sleep(1); \
    if ((++_sp & 255u) == 0u) { if (xb_ld(&(bar)[XB_TMO])) break; if (_sp > XB_SPIN_CAP) { atomicAdd(&(bar)[XB_TMO], 1u); break; } } } } while (0)
struct XcdBarrier { unsigned* bar; unsigned x; volatile LAS unsigned* st; };
__device__ __forceinline__ XcdBarrier xcd_barrier_post(unsigned* bar, volatile LAS unsigned* st) {
    XcdBarrier b; b.bar = bar; b.x = xb_xcc_id(); b.st = st;
    if (threadIdx.x == 0) (void)xb_add(&bar[XB_XCNT(b.x)], 1u);
    return b;
}
__device__ __forceinline__ void xcd_barrier_complete(unsigned* bar, unsigned x, unsigned& nloc, unsigned& nx) {
    const unsigned G = gridDim.x * gridDim.y * gridDim.z;
    unsigned sum, cnt, mine, sp = 0u;
    for (;;) {
        sum = 0u; cnt = 0u; mine = 0u;
#pragma unroll
        for (unsigned j = 0; j < 16; ++j) { const unsigned c = xb_ld(&bar[XB_XCNT(j)]); sum += c; cnt += (c > 0u) ? 1u : 0u; mine = (j == x) ? c : mine; }
        if (sum == G) break;
        __builtin_amdgcn_s_sleep(1);
        if ((++sp & 255u) == 0u) { if (xb_ld(&bar[XB_TMO])) break; if (sp > XB_SPIN_CAP) { atomicAdd(&bar[XB_TMO], 1u); break; } }
    }
    nloc = mine > 0u ? mine : 1u; nx = cnt > 0u ? cnt : 1u;
}
__device__ __forceinline__ void xcd_barrier(const XcdBarrier& b) {
    asm volatile("s_waitcnt vmcnt(0)" ::: "memory");
    __syncthreads();
    if (threadIdx.x == 0) {
        unsigned* bar = b.bar;
        __builtin_amdgcn_s_waitcnt(0);
        unsigned nloc = b.st[0], nx = b.st[1];
        if (nloc == 0u) { xcd_barrier_complete(bar, b.x, nloc, nx); b.st[0] = nloc; b.st[1] = nx; }
        const unsigned old = xb_add(&bar[XB_XSUB(b.x)], 1u);
        const unsigned gen = old / nloc;
        if (old + 1u == (gen + 1u) * nloc) {
            __builtin_amdgcn_fence(__ATOMIC_RELEASE, "agent");
            asm volatile("s_waitcnt vmcnt(0)" ::: "memory");
            const unsigned og = xb_add(&bar[XB_TOP], 1u);
            const unsigned tg = og / nx;
            if (og + 1u == (tg + 1u) * nx) xb_add(&bar[XB_TOPGEN], 1u);
            else XB_SPIN(xb_ld(&bar[XB_TOPGEN]) == tg, bar);
            __builtin_amdgcn_fence(__ATOMIC_ACQUIRE, "agent");
            xb_add(&bar[XB_XGEN(b.x)], 1u);
            asm volatile("s_waitcnt vmcnt(0)" ::: "memory");
        } else {
            XB_SPIN(xb_ld(&bar[XB_XGEN(b.x)]) == gen, bar);
            __builtin_amdgcn_fence(__ATOMIC_ACQUIRE, "agent");
            asm volatile("s_waitcnt vmcnt(0)" ::: "memory");
        }
    }
    __syncthreads();
}

__device__ __forceinline__ void glds16_asm(const void* gsrc, unsigned lds_dst) { unsigned keep;
    asm volatile("s_mov_b32 %0, m0\n\ts_mov_b32 m0, %2\n\ts_nop 0\n\tglobal_load_lds_dwordx4 %1, off\n\ts_mov_b32 m0, %0" : "=&s"(keep) : "v"(gsrc), "s"(lds_dst) : "memory"); }
__device__ __forceinline__ void glds16_asm_s(const void* sbase, unsigned voff, unsigned lds_dst) { unsigned keep;
    asm volatile("s_mov_b32 %0, m0\n\ts_mov_b32 m0, %3\n\ts_nop 0\n\tglobal_load_lds_dwordx4 %1, %2\n\ts_mov_b32 m0, %0" : "=&s"(keep) : "v"(voff), "s"(sbase), "s"(lds_dst) : "memory"); }
__device__ __forceinline__ int swz(int row) { return ((row >> 1) & 7) ^ ((row >> 4) & 1); }
constexpr int GK = 1024, GNT = GK / 64;
#ifndef PFON
#define PFON 1
#endif
struct RowLinear { int row0; __device__ __forceinline__ int operator()(int r) const { return row0 + r; } };
struct RowList { const int* list; int n; __device__ __forceinline__ int operator()(int r) const { return r < n ? list[r] : 0; } };

template <int MODE = 0, class RowMap, class Epi>
__device__ __forceinline__ void gemm_tile(LAS unsigned char* lds, const bf16_t* A, const int lda, const RowMap& rm,
                                          const float* Bw, const int ldb, const int bc0, const int bc1, const Epi& epi, const int pf_id = 0) {
    int tid = threadIdx.x; asm volatile("" : "+v"(tid));
    const int lane = tid & 63, wid = __builtin_amdgcn_readfirstlane(tid >> 6);
    const int wr = wid >> 2, wc = wid & 3, fr = lane & 15, fq = lane >> 4;
    unsigned ao[4];
#pragma unroll
    for (int p = 0; p < 4; ++p) { const int r = 32 * wid + 8 * p + (lane >> 3); const int gr = rm(r); const int lc = (lane & 7) ^ swz(r);
        ao[p] = (unsigned)gr * (unsigned)(lda * 2) + (unsigned)(lc * 16); }
    const unsigned bo = (unsigned)((((lane >> 5) ? bc1 : bc0) + 4 * (lane & 31)) * 4);
    const float* bp = Bw + (size_t)(8 * wid) * ldb;
    unsigned bw[4];
#pragma unroll
    for (int c = 0; c < 4; ++c) { const int row = 32 * (lane >> 3) + 16 * (lane & 1) + 4 * ((lane & 7) >> 1) + c; bw[c] = 65536u + (unsigned)(row * 128 + ((wid ^ swz(row)) << 4)); }
    const int sw = (fr >> 1) & 7;
    f32x4 acc[2][2][4][2];
#pragma unroll
    for (int a = 0; a < 2; ++a)
#pragma unroll
        for (int b = 0; b < 2; ++b)
#pragma unroll
            for (int m = 0; m < 4; ++m)
#pragma unroll
                for (int n = 0; n < 2; ++n) acc[a][b][m][n] = (f32x4){0.f, 0.f, 0.f, 0.f};
    f32x4 breg[8];
    unsigned aro = (unsigned)((64 * wr + fr) * 128 + ((fq ^ sw) << 4));
    unsigned bro = 65536u + (unsigned)((32 * wc + fr) * 128 + ((fq ^ sw) << 4));
    const int pf_row = (8 * pf_id + wid) & 63;
    const unsigned lds0 = (unsigned)(uintptr_t)lds;
    unsigned ldsA = (unsigned)(wid * 4096);
#define G_ISSUE_A(T) do { _Pragma("unroll") for (int p = 0; p < 4; ++p) \
        glds16_asm_s((const char*)A + (T) * 128, ao[p], (unsigned)__builtin_amdgcn_readfirstlane((int)(lds0 + ldsA + p * 1024))); } while (0)
#define G_LOAD_B(T) do { _Pragma("unroll") for (int j = 0; j < 8; ++j) asm volatile("global_load_dwordx4 %0, %1, %2" : "=v"(breg[j]) : "v"(bo), "s"(bp + (size_t)((T) * 64 + j) * ldb) : "memory"); } while (0)
#define G_WAIT_B(N) asm volatile("s_waitcnt vmcnt(" #N ")" : "+v"(breg[0]), "+v"(breg[1]), "+v"(breg[2]), "+v"(breg[3]), "+v"(breg[4]), "+v"(breg[5]), "+v"(breg[6]), "+v"(breg[7]) :: "memory")
#define G_WRITE_B() do { _Pragma("unroll") for (int c = 0; c < 4; ++c) { u32x4 w; w.x = pk_bf16(breg[0][c], breg[1][c]); w.y = pk_bf16(breg[2][c], breg[3][c]); \
        w.z = pk_bf16(breg[4][c], breg[5][c]); w.w = pk_bf16(breg[6][c], breg[7][c]); *(LAS u32x4*)(lds + bw[c]) = w; } } while (0)
#define G_COMPUTE() do { _Pragma("unroll") for (int kk = 0; kk < 2; ++kk) { bf16x8 bf[2][2]; \
        _Pragma("unroll") for (int bj = 0; bj < 2; ++bj) _Pragma("unroll") for (int n = 0; n < 2; ++n) bf[bj][n] = *(const LAS bf16x8*)(lds + (bro ^ (kk * 64 + (n & 1) * 16)) + (128 * bj + 16 * n) * 128); \
        _Pragma("unroll") for (int ai = 0; ai < 2; ++ai) { bf16x8 af[4]; \
            _Pragma("unroll") for (int m = 0; m < 4; ++m) af[m] = *(const LAS bf16x8*)(lds + (aro ^ (kk * 64 + (m & 1) * 16)) + (128 * ai + 16 * m) * 128); \
            _Pragma("unroll") for (int bj = 0; bj < 2; ++bj) _Pragma("unroll") for (int m = 0; m < 4; ++m) _Pragma("unroll") for (int n = 0; n < 2; ++n) \
                acc[ai][bj][m][n] = __builtin_amdgcn_mfma_f32_16x16x32_bf16(bf[bj][n], af[m], acc[ai][bj][m][n], 0, 0, 0); \
            __builtin_amdgcn_sched_barrier(0); } } } while (0)
    G_ISSUE_A(0); G_LOAD_B(0); G_WAIT_B(0); G_WRITE_B(); WG_BARRIER();
    if (wr == 0) __builtin_amdgcn_s_setprio(2); else __builtin_amdgcn_s_setprio(0);
#pragma unroll 1
    for (int t = 0; t < GNT; ++t) {
        ldsA ^= 32768u;
#pragma unroll
        for (int c = 0; c < 4; ++c) bw[c] ^= 32768u;
        if (MODE == 0 || MODE == 1) { if (t + 1 < GNT) { G_ISSUE_A(t + 1); G_LOAD_B(t + 1);
            { const int tp = (t + 3 < GNT) ? t + 3 : GNT - 1;
                glds16_asm_s(bp + (ptrdiff_t)(tp * 64 + pf_row - 8 * wid) * ldb, bo, (unsigned)__builtin_amdgcn_readfirstlane((int)(lds0 + 135168u + wid * 1024))); } } }
        __builtin_amdgcn_sched_barrier(0);
        if (MODE != 6) G_COMPUTE();
        if (t + 1 < GNT) { if (MODE == 0 || MODE == 1) G_WAIT_B(1); if (MODE != 7 && MODE != 8) G_WRITE_B(); }
        if (MODE != 8) { asm volatile("s_waitcnt vmcnt(1) lgkmcnt(0)" ::: "memory"); __builtin_amdgcn_s_barrier(); asm volatile("" ::: "memory"); }
        aro ^= 32768u; bro ^= 32768u;
    }
    __builtin_amdgcn_s_setprio(0);
    asm volatile("s_waitcnt vmcnt(0)" ::: "memory");
    if (MODE == 0) epi(acc, wr, wc, fr, fq);
    else { float s_ = 0.f;
#pragma unroll
        for (int a = 0; a < 2; ++a)
#pragma unroll
            for (int b = 0; b < 2; ++b)
#pragma unroll
                for (int m = 0; m < 4; ++m)
#pragma unroll
                    for (int n = 0; n < 2; ++n) s_ += (acc[a][b][m][n][0] + acc[a][b][m][n][1]) + (acc[a][b][m][n][2] + acc[a][b][m][n][3]);
        if (s_ == 12345.678f) *(float*)(const_cast<float*>(Bw)) = s_; }
#undef G_ISSUE_A
#undef G_LOAD_B
#undef G_WRITE_B
#undef G_COMPUTE
}

typedef f32x4 Acc[2][2][4][2];
#define EPI_LOOP_ROWS for (int ai = 0; ai < 2; ++ai) _Pragma("unroll") for (int m = 0; m < 4; ++m)
struct EpiIn { bf16_t* out; int row0, col0; bool act;
    __device__ __forceinline__ void operator()(const Acc& acc, int wr, int wc, int fr, int fq) const {
#pragma unroll
        EPI_LOOP_ROWS { const int row = row0 + 128 * ai + 64 * wr + 16 * m + fr;
#pragma unroll
            for (int bj = 0; bj < 2; ++bj) { f32x4 v0 = acc[ai][bj][m][0], v1 = acc[ai][bj][m][1];
                if (act) {
#pragma unroll
                    for (int r = 0; r < 4; ++r) { v0[r] = gelu_tanh(v0[r]); v1[r] = gelu_tanh(v1[r]); } }
                u32x4 w; w.x = pk_bf16(v0[0], v0[1]); w.y = pk_bf16(v0[2], v0[3]); w.z = pk_bf16(v1[0], v1[1]); w.w = pk_bf16(v1[2], v1[3]);
                *(u32x4*)(out + (size_t)row * INC + col0 + 128 * bj + 32 * wc + 8 * fq) = w; } }
    } };
struct EpiKV { bf16_t* km; bf16_t* vt; int row0, col0;
    __device__ __forceinline__ void operator()(const Acc& acc, int wr, int wc, int fr, int fq) const {
#pragma unroll
        EPI_LOOP_ROWS { const int row = row0 + 128 * ai + 64 * wr + 16 * m + fr;
#pragma unroll
            for (int bj = 0; bj < 2; ++bj) { const f32x4 v0 = acc[ai][bj][m][0], v1 = acc[ai][bj][m][1]; const int col = col0 + 128 * bj + 32 * wc + 8 * fq;
                if (col0 < DM) { u32x4 w; w.x = pk_bf16(v0[0], v0[1]); w.y = pk_bf16(v0[2], v0[3]); w.z = pk_bf16(v1[0], v1[1]); w.w = pk_bf16(v1[2], v1[3]);
                    *(u32x4*)(km + (size_t)row * DM + col) = w; }
                else { const int b = row >> 8, mm = row & 255; bf16_t* base = vt + ((size_t)(b * DM + (col - DM))) * MEML + mm;
#pragma unroll
                    for (int r = 0; r < 4; ++r) { base[(size_t)r * MEML] = (bf16_t)(pk_bf16(v0[r], 0.f) & 0xffffu); base[(size_t)(4 + r) * MEML] = (bf16_t)(pk_bf16(v1[r], 0.f) & 0xffffu); } } } }
    } };
struct EpiResid { const float* xprev; float* out; int row0, col0;
    __device__ __forceinline__ void operator()(const Acc& acc, int wr, int wc, int fr, int fq) const {
#pragma unroll
        EPI_LOOP_ROWS { const int row = row0 + 128 * ai + 64 * wr + 16 * m + fr;
#pragma unroll
            for (int bj = 0; bj < 2; ++bj) { const size_t off = (size_t)row * DM + col0 + 128 * bj + 32 * wc + 8 * fq;
                const f32x4 x0 = *(const f32x4*)(xprev + off), x1 = *(const f32x4*)(xprev + off + 4);
                *(f32x4*)(out + off) = x0 * ALPHA + acc[ai][bj][m][0]; *(f32x4*)(out + off + 4) = x1 * ALPHA + acc[ai][bj][m][1]; } }
    } };
struct EpiBf { bf16_t* out; int row0, col0; float scale;
    __device__ __forceinline__ void operator()(const Acc& acc, int wr, int wc, int fr, int fq) const {
#pragma unroll
        EPI_LOOP_ROWS { const int row = row0 + 128 * ai + 64 * wr + 16 * m + fr;
#pragma unroll
            for (int bj = 0; bj < 2; ++bj) { const f32x4 v0 = acc[ai][bj][m][0] * scale, v1 = acc[ai][bj][m][1] * scale;
                u32x4 w; w.x = pk_bf16(v0[0], v0[1]); w.y = pk_bf16(v0[2], v0[3]); w.z = pk_bf16(v1[0], v1[1]); w.w = pk_bf16(v1[2], v1[3]);
                *(u32x4*)(out + (size_t)row * DM + col0 + 128 * bj + 32 * wc + 8 * fq) = w; } }
    } };
struct EpiSwiglu { bf16_t* out; const float* bgu; int row0, colg;
    __device__ __forceinline__ void operator()(const Acc& acc, int wr, int wc, int fr, int fq) const {
        const int c = colg + 32 * wc + 8 * fq;
        const f32x4 bg0 = *(const f32x4*)(bgu + c), bg1 = *(const f32x4*)(bgu + c + 4), bu0 = *(const f32x4*)(bgu + DM + c), bu1 = *(const f32x4*)(bgu + DM + c + 4);
#pragma unroll
        EPI_LOOP_ROWS { const int row = row0 + 128 * ai + 64 * wr + 16 * m + fr;
            f32x4 o[2];
#pragma unroll
            for (int n = 0; n < 2; ++n) { const f32x4 g4 = acc[ai][0][m][n] + (n ? bg1 : bg0), u4 = acc[ai][1][m][n] + (n ? bu1 : bu0);
#pragma unroll
                for (int r = 0; r < 4; ++r) { const float g = fminf(g4[r], 7.0f), u = fminf(fmaxf(u4[r], -7.0f), 7.0f);
                    const float sg = fast_rcp(1.0f + fast_exp2(-1.702f * 1.4426950408889634f * g));
                    o[n][r] = (u + 1.0f) * (g * sg); } }
            u32x4 w; w.x = pk_bf16(o[0][0], o[0][1]); w.y = pk_bf16(o[0][2], o[0][3]); w.z = pk_bf16(o[1][0], o[1][1]); w.w = pk_bf16(o[1][2], o[1][3]);
            *(u32x4*)(out + (size_t)row * DM + c) = w; }
    } };
struct EpiDown { bf16_t* out; const float* bd; const float* gate; int row0, col0;
    __device__ __forceinline__ void operator()(const Acc& acc, int wr, int wc, int fr, int fq) const {
#pragma unroll
        EPI_LOOP_ROWS { const int tr = 128 * ai + 64 * wr + 16 * m + fr; const float gt = gate[tr];
#pragma unroll
            for (int bj = 0; bj < 2; ++bj) { const int col = col0 + 128 * bj + 32 * wc + 8 * fq;
                const f32x4 v0 = (acc[ai][bj][m][0] + *(const f32x4*)(bd + col)) * gt, v1 = (acc[ai][bj][m][1] + *(const f32x4*)(bd + col + 4)) * gt;
                u32x4 w; w.x = pk_bf16(v0[0], v0[1]); w.y = pk_bf16(v0[2], v0[3]); w.z = pk_bf16(v1[0], v1[1]); w.w = pk_bf16(v1[2], v1[3]);
                *(u32x4*)(out + (size_t)(row0 + tr) * DM + col) = w; } }
    } };

#ifndef PHM
#define PHM 0xFFFF
#endif
#define PH(k) ((PHM >> (k)) & 1)
#ifndef REPM
#define REPM 0x0
#endif
#define PROBE_MODE 8
#define REP(k) for (int rep_ = 0; rep_ < 1 + ((REPM >> (k)) & 1); ++rep_)
struct Params { const float* in[20]; float* out; unsigned char* ws; };

__device__ __forceinline__ void ln_row(const float* src, const float* g, const float* b, float* dst, bf16_t* dstb, int lane) {
    f32x4 v[4]; float s = 0.f;
#pragma unroll
    for (int j = 0; j < 4; ++j) { v[j] = *(const f32x4*)(src + 256 * j + 4 * lane); s += (v[j][0] + v[j][1]) + (v[j][2] + v[j][3]); }
    const float mean = wave_sum(s) * (1.0f / DM); float q = 0.f;
#pragma unroll
    for (int j = 0; j < 4; ++j) { v[j] = v[j] - mean; q += (v[j][0] * v[j][0] + v[j][1] * v[j][1]) + (v[j][2] * v[j][2] + v[j][3] * v[j][3]); }
    const float rstd = 1.0f / sqrtf(wave_sum(q) * (1.0f / DM) + LN_EPS);
#pragma unroll
    for (int j = 0; j < 4; ++j) { const f32x4 gg = *(const f32x4*)(g + 256 * j + 4 * lane), bb = *(const f32x4*)(b + 256 * j + 4 * lane);
        const f32x4 o = v[j] * rstd * gg + bb; *(f32x4*)(dst + 256 * j + 4 * lane) = o;
        u32x2 w; w.x = pk_bf16(o[0], o[1]); w.y = pk_bf16(o[2], o[3]); *(u32x2*)(dstb + 256 * j + 4 * lane) = w; }
}

__global__ void __launch_bounds__(512, 2) mega_fwd(Params P) {
    extern __shared__ __attribute__((aligned(16))) unsigned char lds_raw[];
    LAS unsigned char* lds = (LAS unsigned char*)lds_raw;
#define PHASE_IDS() int tid = threadIdx.x; asm volatile("" : "+v"(tid)); const int lane = tid & 63, wid = __builtin_amdgcn_readfirstlane(tid >> 6); (void)lane; (void)wid
    const int G = gridDim.x, bx = blockIdx.x;
    const int vcu = (G % 8 == 0) ? (bx % 8) * (G / 8) + bx / 8 : bx;
    unsigned char* ws = P.ws;
    unsigned* ctl = (unsigned*)(ws + WS_CTL);
    volatile LAS unsigned* misc = (volatile LAS unsigned*)(lds + LDS_MISC);
    { PHASE_IDS(); if (tid < 64) misc[tid] = 0u; }
    __syncthreads();
    XcdBarrier bar = xcd_barrier_post(ctl + CW_BAR, misc + 8);
#define GRID_BAR() xcd_barrier(bar)

    bf16_t* XB = (bf16_t*)(ws + WS_XB); bf16_t* MEMB = (bf16_t*)(ws + WS_MEMB); bf16_t* PROJ = (bf16_t*)(ws + WS_PROJ);
    bf16_t* KM = (bf16_t*)(ws + WS_KM); bf16_t* VT = (bf16_t*)(ws + WS_VT); bf16_t* YMIX = (bf16_t*)(ws + WS_YMIX);
    float* SBUF = (float*)(ws + WS_SBUF); float* X1 = (float*)(ws + WS_X1); bf16_t* X1B = (bf16_t*)(ws + WS_X1B);
    bf16_t* QM = (bf16_t*)(ws + WS_QM); bf16_t* OM = (bf16_t*)(ws + WS_OM); float* X2 = (float*)(ws + WS_X2); bf16_t* X2B = (bf16_t*)(ws + WS_X2B);
    bf16_t* ABUF = (bf16_t*)(ws + WS_ABUF); bf16_t* YBUF = (bf16_t*)(ws + WS_YBUF); float* X3 = (float*)(ws + WS_X3);

    {
        PHASE_IDS();
        const float* x = P.in[0]; const float* mem = P.in[1];
        const int nthr = G * 512, gt = bx * 512 + tid;
        for (int i = gt; i < NTOK * DM / 4; i += nthr) { const f32x4 v = *(const f32x4*)(x + (size_t)i * 4); u32x2 w; w.x = pk_bf16(v[0], v[1]); w.y = pk_bf16(v[2], v[3]); *(u32x2*)(XB + (size_t)i * 4) = w; }
        for (int i = gt; i < MEMROWS * DM / 4; i += nthr) { const f32x4 v = *(const f32x4*)(mem + (size_t)i * 4); u32x2 w; w.x = pk_bf16(v[0], v[1]); w.y = pk_bf16(v[2], v[3]); *(u32x2*)(MEMB + (size_t)i * 4) = w; }
    }
    GRID_BAR();

#pragma unroll 1
    for (int l = 0; l < DEPTH; ++l) {
        const float* xin = (l == 0) ? P.in[0] : X3;
        float* xout = (l == DEPTH - 1) ? P.out : X3;
        const float* w_in = P.in[2] + (size_t)l * DM * INC;
        const float* sgu_g = P.in[3] + l * 512; const float* sgu_b = P.in[4] + l * 512;
        const float* w_sp = P.in[5] + (size_t)l * 4 * 128 * 128; const float* b_sp = P.in[6] + l * 4 * 128;
        const float* grp_g = P.in[7] + l * DM;
        const float* w_out = P.in[8] + (size_t)l * DM * DM;
        const float* wq = P.in[9] + (size_t)l * DM * DM; const float* wkv = P.in[10] + (size_t)l * DM * 2 * DM; const float* wo = P.in[11] + (size_t)l * DM * DM;
        const float* w_router = P.in[12] + (size_t)l * DM * NE; const float* b_router = P.in[13] + l * NE;
        const float* w_gu = P.in[14] + (size_t)l * NE * DM * 2 * DM; const float* b_gu = P.in[15] + (size_t)l * NE * 2 * DM;
        const float* w_down = P.in[16] + (size_t)l * NE * DM * DM; const float* b_down = P.in[17] + (size_t)l * NE * DM;
        const float* ln_g = P.in[18] + l * 3 * DM; const float* ln_b = P.in[19] + l * 3 * DM;
        unsigned* cnt = ctl + CW_CNT + l * 64;
        int* list_tok = (int*)(ws + WS_ROUTE + l * ROUTE_LAYER); float* list_gate = (float*)(ws + WS_ROUTE + l * ROUTE_LAYER + 2 * MiB); int* sel = (int*)(ws + WS_ROUTE + l * ROUTE_LAYER + 4 * MiB);

        if (PH(1)) REP(1)
#pragma unroll 1
        for (int u = vcu; u < 704; u += G) {
            if (u < 640) { const int ct = u >> 6, rt = u & 63;
                EpiIn E{PROJ, 256 * rt, 256 * ct, ct < 4}; RowLinear rm{256 * rt};
                gemm_tile(lds, XB, DM, rm, w_in, INC, 256 * ct, 256 * ct + 128, E, rt & 7);
            } else { const int v = u - 640, ct = v >> 3, rt = v & 7;
                EpiKV E{KM, VT, 256 * rt, 256 * ct}; RowLinear rm{256 * rt};
                gemm_tile(lds, MEMB, DM, rm, wkv, 2 * DM, 256 * ct, 256 * ct + 128, E, rt & 7);
            }
        }
        GRID_BAR();

        if (PH(2)) REP(2)
        {
            PHASE_IDS();
#pragma unroll 1
            for (int u = vcu; u < 512; u += G) {
                const int g = u & 3, c = (u >> 2) & 15, b = u >> 6; const int tok0 = b * SEQ + 128 * c;
                {
                    const int tp = tid >> 3, cg = tid & 7;
                    float vv[2][16];
#pragma unroll
                    for (int s = 0; s < 2; ++s) { const bf16_t* src = PROJ + (size_t)(tok0 + 2 * tp + s) * INC + 512 + 128 * g + 16 * cg;
                        const u32x4 a = *(const u32x4*)src, bq = *(const u32x4*)(src + 8);
#pragma unroll
                        for (int e = 0; e < 4; ++e) { vv[s][2 * e] = bf2f(a[e] & 0xffffu); vv[s][2 * e + 1] = bf2f(a[e] >> 16); vv[s][8 + 2 * e] = bf2f(bq[e] & 0xffffu); vv[s][8 + 2 * e + 1] = bf2f(bq[e] >> 16); }
                        float sm = 0.f;
#pragma unroll
                        for (int e = 0; e < 16; ++e) sm += vv[s][e];
                        sm += __shfl_xor(sm, 1); sm += __shfl_xor(sm, 2); sm += __shfl_xor(sm, 4);
                        const float mean = sm * (1.0f / 128.0f); float q = 0.f;
#pragma unroll
                        for (int e = 0; e < 16; ++e) { vv[s][e] -= mean; q += vv[s][e] * vv[s][e]; }
                        q += __shfl_xor(q, 1); q += __shfl_xor(q, 2); q += __shfl_xor(q, 4);
                        const float rstd = 1.0f / sqrtf(q * (1.0f / 128.0f) + LN_EPS);
#pragma unroll
                        for (int e = 0; e < 16; ++e) vv[s][e] = vv[s][e] * rstd * sgu_g[128 * g + 16 * cg + e] + sgu_b[128 * g + 16 * cg + e];
                    }
                    const int s0 = 2 * tp, chunk = s0 >> 3;
#pragma unroll
                    for (int e = 0; e < 16; ++e) { const int d = 16 * cg + e;
                        *(LAS unsigned*)(lds + d * 256 + ((chunk ^ (d & 15)) << 4) + (s0 & 7) * 2) = pk_bf16(vv[0][e], vv[1][e]); }
                }
                WG_BARRIER();
                {
                    const int fr = lane & 15, fq = lane >> 4, t = 16 * wid + fr;
                    f32x4 acc[8];
#pragma unroll
                    for (int nb = 0; nb < 8; ++nb) acc[nb] = (f32x4){0.f, 0.f, 0.f, 0.f};
                    const float* wrow = w_sp + ((size_t)g * 128 + t) * 128;
                    const int nkk = (wid >> 1) + 1;
#pragma unroll 1
                    for (int kk = 0; kk < nkk; ++kk) {
                        const int sb = 32 * kk + 8 * fq;
                        const f32x4 w0 = *(const f32x4*)(wrow + sb), w1 = *(const f32x4*)(wrow + sb + 4);
                        float wv[8] = {w0[0], w0[1], w0[2], w0[3], w1[0], w1[1], w1[2], w1[3]};
#pragma unroll
                        for (int j = 0; j < 8; ++j) wv[j] = (sb + j <= t) ? wv[j] : 0.f;
                        u32x4 wp; wp.x = pk_bf16(wv[0], wv[1]); wp.y = pk_bf16(wv[2], wv[3]); wp.z = pk_bf16(wv[4], wv[5]); wp.w = pk_bf16(wv[6], wv[7]);
                        const bf16x8 wf = __builtin_bit_cast(bf16x8, wp);
#pragma unroll
                        for (int nb = 0; nb < 8; ++nb) { const int d = 16 * nb + fr;
                            const bf16x8 vf = *(const LAS bf16x8*)(lds + d * 256 + ((((4 * kk + fq) ^ (d & 15))) << 4));
                            acc[nb] = __builtin_amdgcn_mfma_f32_16x16x32_bf16(vf, wf, acc[nb], 0, 0, 0); }
                    }
                    const float bias = b_sp[g * 128 + t];
                    const bf16_t* urow = PROJ + (size_t)(tok0 + t) * INC + 128 * g;
                    float ms = 0.f;
#pragma unroll
                    for (int nb = 0; nb < 8; ++nb) { const u32x2 uu = *(const u32x2*)(urow + 16 * nb + 4 * fq);
                        const float u0 = bf2f(uu.x & 0xffffu), u1 = bf2f(uu.x >> 16), u2 = bf2f(uu.y & 0xffffu), u3 = bf2f(uu.y >> 16);
                        acc[nb][0] = u0 * (acc[nb][0] + bias); acc[nb][1] = u1 * (acc[nb][1] + bias); acc[nb][2] = u2 * (acc[nb][2] + bias); acc[nb][3] = u3 * (acc[nb][3] + bias);
                        ms += (acc[nb][0] * acc[nb][0] + acc[nb][1] * acc[nb][1]) + (acc[nb][2] * acc[nb][2] + acc[nb][3] * acc[nb][3]); }
                    ms += __shfl_xor(ms, 16); ms += __shfl_xor(ms, 32);
                    const float sc = 1.0f / sqrtf(ms * (1.0f / 128.0f) + RMS_EPS);
                    bf16_t* yrow = YMIX + (size_t)(tok0 + t) * DM + 128 * g;
#pragma unroll
                    for (int nb = 0; nb < 8; ++nb) { const f32x4 gg = *(const f32x4*)(grp_g + 128 * g + 16 * nb + 4 * fq); const f32x4 o = acc[nb] * sc * gg;
                        u32x2 w; w.x = pk_bf16(o[0], o[1]); w.y = pk_bf16(o[2], o[3]); *(u32x2*)(yrow + 16 * nb + 4 * fq) = w; }
                }
                WG_BARRIER();
            }
#pragma unroll 1
            for (int pp = 2 * vcu; pp < 1024; pp = ((pp & 1) ? pp + 2 * G - 1 : pp + 1)) {
                const int pr = pp >> 1, bh = pr >> 3, ip = pr & 7, qi = (pp & 1) ? (15 - ip) : ip;
                const int b = bh >> 3, h = bh & 7; const int tokb = b * SEQ;
                const int fr = lane & 15, fq = lane >> 4, tq = 128 * qi + 16 * wid + fr;
                bf16x8 qf[2];
#pragma unroll
                for (int kk = 0; kk < 2; ++kk) qf[kk] = *(const bf16x8*)(PROJ + (size_t)(tokb + tq) * INC + 1024 + 64 * h + 32 * kk + 8 * fq);
                f32x4 oacc[4];
#pragma unroll
                for (int db = 0; db < 4; ++db) oacc[db] = (f32x4){0.f, 0.f, 0.f, 0.f};
                float R = 0.f;
                const int ntile = 2 * qi + 2;
                LAS volatile unsigned* flg = (LAS volatile unsigned*)(lds + LDS_MISC + 64);
                if (lane == 0) flg[(ntile & 1) * 8 + wid] = 0u;
#pragma unroll 1
                for (int jt = ntile - 1; jt >= 0; --jt) {
                    LAS unsigned char* vbuf = lds + (jt & 1) * 8704;
                    {
                        const int kv = tid >> 3, ch = tid & 7;
                        const u32x4 a = *(const u32x4*)(PROJ + (size_t)(tokb + 64 * jt + kv) * INC + 2048 + 64 * h + 8 * ch);
#pragma unroll
                        for (int e = 0; e < 4; ++e) { *(LAS bf16_t*)(vbuf + (8 * ch + 2 * e) * 136 + 2 * kv) = (bf16_t)(a[e] & 0xffffu); *(LAS bf16_t*)(vbuf + (8 * ch + 2 * e + 1) * 136 + 2 * kv) = (bf16_t)(a[e] >> 16); }
                    }
                    WG_BARRIER();
                    { const LAS volatile unsigned* fp = flg + ((jt + 1) & 1) * 8;
                      if ((fp[0] & fp[1] & fp[2] & fp[3] & fp[4] & fp[5] & fp[6] & fp[7]) != 0u) break; }
                    if (64 * jt < 128 * qi + 16 * wid + 15) {
                        f32x4 z[4];
#pragma unroll
                        for (int nb = 0; nb < 4; ++nb) { z[nb] = (f32x4){0.f, 0.f, 0.f, 0.f};
#pragma unroll
                            for (int kk = 0; kk < 2; ++kk) { const bf16x8 kf = *(const bf16x8*)(PROJ + (size_t)(tokb + 64 * jt + 16 * nb + fr) * INC + 1536 + 64 * h + 32 * kk + 8 * fq);
                                z[nb] = __builtin_amdgcn_mfma_f32_16x16x32_bf16(kf, qf[kk], z[nb], 0, 0, 0); } }
                        float lnot[4][4], lsig[4][4], gsum[4];
#pragma unroll
                        for (int nb = 0; nb < 4; ++nb) { gsum[nb] = 0.f;
#pragma unroll
                            for (int r = 0; r < 4; ++r) { const float zz = z[nb][r] * 0.125f; const int s = 64 * jt + 16 * nb + 4 * fq + r;
                                const float sp = fmaxf(zz, 0.f) + 0.6931471805599453f * fast_log2(1.0f + fast_exp2(-1.4426950408889634f * fabsf(zz)));
                                const bool valid = s < tq;
                                lnot[nb][r] = valid ? -sp : 0.f; lsig[nb][r] = valid ? (zz - sp) : -1.0e30f; gsum[nb] += lnot[nb][r]; } }
                        float off = R;
                        u32x4 pw[2];
#pragma unroll
                        for (int nb = 3; nb >= 0; --nb) {
                            const float x1 = __shfl_xor(gsum[nb], 16), x2 = __shfl_xor(gsum[nb], 32), x3 = __shfl_xor(gsum[nb], 48);
                            const float tot = (gsum[nb] + x1) + (x2 + x3);
                            const float suf = ((fq & 1) ? 0.f : x1) + ((fq & 2) ? 0.f : (x2 + x3));
                            float c3 = off + suf, c2 = c3 + lnot[nb][3], c1 = c2 + lnot[nb][2], c0 = c1 + lnot[nb][1];
                            const float p0 = fast_exp2(1.4426950408889634f * (lsig[nb][0] + c0)), p1 = fast_exp2(1.4426950408889634f * (lsig[nb][1] + c1));
                            const float p2 = fast_exp2(1.4426950408889634f * (lsig[nb][2] + c2)), p3 = fast_exp2(1.4426950408889634f * (lsig[nb][3] + c3));
                            const unsigned lo = pk_bf16(p0, p1), hi = pk_bf16(p2, p3);
                            if (nb == 0) { pw[0].x = lo; pw[0].y = hi; } else if (nb == 1) { pw[0].z = lo; pw[0].w = hi; } else if (nb == 2) { pw[1].x = lo; pw[1].y = hi; } else { pw[1].z = lo; pw[1].w = hi; }
                            off += tot;
                        }
                        R = off;
#pragma unroll
                        for (int kk = 0; kk < 2; ++kk) { const bf16x8 pf = __builtin_bit_cast(bf16x8, pw[kk]);
#pragma unroll
                            for (int db = 0; db < 4; ++db) { const LAS unsigned char* vp = vbuf + (16 * db + fr) * 136 + (32 * kk + 4 * fq) * 2;
                                const u32x2 v0 = *(const LAS u32x2*)vp, v1 = *(const LAS u32x2*)(vp + 32);
                                u32x4 vv; vv.x = v0.x; vv.y = v0.y; vv.z = v1.x; vv.w = v1.y;
                                oacc[db] = __builtin_amdgcn_mfma_f32_16x16x32_bf16(__builtin_bit_cast(bf16x8, vv), pf, oacc[db], 0, 0, 0); } }
                    }
                    { const bool done = __all(R < -120.0f); if (lane == 0) flg[(jt & 1) * 8 + wid] = done ? 1u : 0u; }
                }
                float ms = 0.f;
#pragma unroll
                for (int db = 0; db < 4; ++db) ms += (oacc[db][0] * oacc[db][0] + oacc[db][1] * oacc[db][1]) + (oacc[db][2] * oacc[db][2] + oacc[db][3] * oacc[db][3]);
                ms += __shfl_xor(ms, 16); ms += __shfl_xor(ms, 32);
                const float sc = 1.0f / sqrtf(ms * (1.0f / 64.0f) + RMS_EPS);
                bf16_t* yrow = YMIX + (size_t)(tokb + tq) * DM + 512 + 64 * h;
#pragma unroll
                for (int db = 0; db < 4; ++db) { const f32x4 gg = *(const f32x4*)(grp_g + 512 + 64 * h + 16 * db + 4 * fq); const f32x4 o = oacc[db] * sc * gg;
                    u32x2 w; w.x = pk_bf16(o[0], o[1]); w.y = pk_bf16(o[2], o[3]); *(u32x2*)(yrow + 16 * db + 4 * fq) = w; }
                WG_BARRIER();
            }
        }
        GRID_BAR();

        if (PH(3)) REP(3)
#pragma unroll 1
        for (int u = vcu; u < 256; u += G) { const int ct = u >> 6, rt = u & 63;
            EpiResid E{xin, SBUF, 256 * rt, 256 * ct}; RowLinear rm{256 * rt};
            gemm_tile(lds, YMIX, DM, rm, w_out, DM, 256 * ct, 256 * ct + 128, E, rt & 7); }
        GRID_BAR();
        if (PH(4)) REP(4)
        { PHASE_IDS();
#pragma unroll 1
        for (int row = vcu * 8 + wid; row < NTOK; row += G * 8) ln_row(SBUF + (size_t)row * DM, ln_g, ln_b, X1 + (size_t)row * DM, X1B + (size_t)row * DM, lane); }
        GRID_BAR();
        if (PH(5)) REP(5)
#pragma unroll 1
        for (int u = vcu; u < 256; u += G) { const int ct = u >> 6, rt = u & 63;
            EpiBf E{QM, 256 * rt, 256 * ct, 0.0625f}; RowLinear rm{256 * rt};
            gemm_tile(lds, X1B, DM, rm, wq, DM, 256 * ct, 256 * ct + 128, E, rt & 7); }
        GRID_BAR();
        if (PH(6)) REP(6)
        {
            PHASE_IDS();
            const int fr = lane & 15, fq = lane >> 4;
            const unsigned lds0 = (unsigned)(uintptr_t)lds;
            const int nun = (512 - vcu + G - 1) / G;
            const int rl = 2 * wid + (lane >> 5);
            const unsigned klo = (unsigned)(rl * 2048 + (((lane & 31) ^ rl) << 4));
            const unsigned vlo = (unsigned)(rl * 512 + (((lane & 31) ^ rl) << 4));
#define MA_ISSUE(S) do { const int u_ = vcu + ((S) >> 2) * G, st_ = (S) & 3; const int h_ = (u_ >> 4) & 3, b_ = u_ >> 6; const unsigned dst_ = lds0 + (unsigned)(((S) & 1) * 65536 + wid * 1024); \
        if (st_ < 2) { const bf16_t* src_ = KM + (size_t)(b_ * MEML + 128 * st_) * DM + 256 * h_; \
            _Pragma("unroll") for (int p = 0; p < 8; ++p) glds16_asm_s((const char*)src_ + p * 32768, klo, (unsigned)__builtin_amdgcn_readfirstlane((int)(dst_ + p * 8192))); } \
        else { const bf16_t* src_ = VT + (size_t)(b_ * DM + 256 * h_ + 128 * (st_ - 2)) * MEML; \
            _Pragma("unroll") for (int p = 0; p < 8; ++p) glds16_asm_s((const char*)src_ + p * 8192, vlo, (unsigned)__builtin_amdgcn_readfirstlane((int)(dst_ + p * 8192))); } } while (0)
            if (nun > 0) MA_ISSUE(0);
            const unsigned kb0 = (unsigned)(fr * 512 + ((fq ^ fr) << 4));
            const unsigned vb0 = (unsigned)(fr * 512 + ((((fq >> 1) ^ fr)) << 4) + 8 * (fq & 1));
#define MA_SYNC() do { asm volatile("s_waitcnt vmcnt(0) lgkmcnt(0)" ::: "memory"); __builtin_amdgcn_s_barrier(); asm volatile("" ::: "memory"); } while (0)
#define MA_KSTAGE(BUF, SOFF) do { _Pragma("unroll") for (int mb = 0; mb < 8; ++mb) { f32x4 a = (f32x4){0.f, 0.f, 0.f, 0.f}; \
        _Pragma("unroll") for (int kk = 0; kk < 8; ++kk) { const bf16x8 kf = *(const LAS bf16x8*)(lds + (BUF) * 65536 + (kb0 ^ (unsigned)(kk * 64)) + mb * 8192); a = __builtin_amdgcn_mfma_f32_16x16x32_bf16(kf, qf[kk], a, 0, 0, 0); } \
        sacc[(SOFF) + mb] = a; } } while (0)
#define MA_VSTAGE(BUF, HV) do { bf16_t* orow = OM + (size_t)tq * DM + 256 * h + 128 * (HV); \
        _Pragma("unroll 2") for (int db = 0; db < 8; ++db) { f32x4 o = (f32x4){0.f, 0.f, 0.f, 0.f}; \
            _Pragma("unroll") for (int kk = 0; kk < 8; ++kk) { const unsigned a1 = (vb0 ^ (unsigned)(kk * 64)) + db * 8192; \
                const u32x2 v0 = *(const LAS u32x2*)(lds + (BUF) * 65536 + a1), v1 = *(const LAS u32x2*)(lds + (BUF) * 65536 + (a1 ^ 32u)); \
                u32x4 vv; vv.x = v0.x; vv.y = v0.y; vv.z = v1.x; vv.w = v1.y; \
                o = __builtin_amdgcn_mfma_f32_16x16x32_bf16(__builtin_bit_cast(bf16x8, vv), __builtin_bit_cast(bf16x8, pw[kk]), o, 0, 0, 0); } \
            o = o * rden; u32x2 w; w.x = pk_bf16(o[0], o[1]); w.y = pk_bf16(o[2], o[3]); *(u32x2*)(orow + 16 * db + 4 * fq) = w; } } while (0)
#pragma unroll 1
            for (int ui = 0; ui < nun; ++ui) {
                const int u = vcu + ui * G; const int qb = u & 15, h = (u >> 4) & 3, b = u >> 6;
                const int tq = b * SEQ + 128 * qb + 16 * wid + fr;
                u32x4 pw[8]; float rden;
                {
                    f32x4 sacc[16]; bf16x8 qf[8];
                    MA_SYNC(); MA_ISSUE(4 * ui + 1);
#pragma unroll
                    for (int kk = 0; kk < 8; ++kk) qf[kk] = *(const bf16x8*)(QM + (size_t)tq * DM + 256 * h + 32 * kk + 8 * fq);
                    MA_KSTAGE(0, 0);
                    MA_SYNC(); MA_ISSUE(4 * ui + 2);
                    MA_KSTAGE(1, 8);
                    float mx = -3.0e38f;
#pragma unroll
                    for (int mb = 0; mb < 16; ++mb) mx = fmaxf(mx, fmaxf(fmaxf(sacc[mb][0], sacc[mb][1]), fmaxf(sacc[mb][2], sacc[mb][3])));
                    mx = fmaxf(mx, __shfl_xor(mx, 16)); mx = fmaxf(mx, __shfl_xor(mx, 32));
                    float den = 0.f;
#pragma unroll
                    for (int mb = 0; mb < 16; ++mb) {
                        const float p0 = fast_exp2(1.4426950408889634f * (sacc[mb][0] - mx)), p1 = fast_exp2(1.4426950408889634f * (sacc[mb][1] - mx));
                        const float p2 = fast_exp2(1.4426950408889634f * (sacc[mb][2] - mx)), p3 = fast_exp2(1.4426950408889634f * (sacc[mb][3] - mx));
                        den += (p0 + p1) + (p2 + p3);
                        const unsigned lo = pk_bf16(p0, p1), hi = pk_bf16(p2, p3);
                        if (mb & 1) { pw[mb >> 1].z = lo; pw[mb >> 1].w = hi; } else { pw[mb >> 1].x = lo; pw[mb >> 1].y = hi; }
                    }
                    den += __shfl_xor(den, 16); den += __shfl_xor(den, 32);
                    rden = 1.0f / den;
                }
                MA_SYNC(); MA_ISSUE(4 * ui + 3);
                MA_VSTAGE(0, 0);
                MA_SYNC(); if (ui + 1 < nun) MA_ISSUE(4 * ui + 4);
                MA_VSTAGE(1, 1);
            }
#undef MA_SYNC
#undef MA_KSTAGE
#undef MA_VSTAGE
#undef MA_ISSUE
        }
        GRID_BAR();
        if (PH(7)) REP(7)
#pragma unroll 1
        for (int u = vcu; u < 256; u += G) { const int ct = u >> 6, rt = u & 63;
            EpiResid E{X1, SBUF, 256 * rt, 256 * ct}; RowLinear rm{256 * rt};
            gemm_tile(lds, OM, DM, rm, wo, DM, 256 * ct, 256 * ct + 128, E, rt & 7); }
        GRID_BAR();
        if (PH(8)) REP(8)
#pragma unroll 1
        for (int ch = vcu; ch < NTOK / 64; ch += G) {
            PHASE_IDS();
            const int r0 = ch * 64;
#pragma unroll 1
            for (int i = 0; i < 8; ++i) { const int row = r0 + 8 * wid + i; ln_row(SBUF + (size_t)row * DM, ln_g + DM, ln_b + DM, X2 + (size_t)row * DM, X2B + (size_t)row * DM, lane); }
            WG_BARRIER();
            {
                const int fr = lane & 15, fq = lane >> 4, tg = wid & 3, kh = wid >> 2, t0 = r0 + 16 * tg;
                unsigned* cntp = rep_ ? cnt + 32 : cnt; int* ltok = rep_ ? (int*)ABUF : list_tok; float* lgate = rep_ ? (float*)ABUF + 4 * MiB : list_gate; int* selp = rep_ ? (int*)ABUF + 8 * MiB : sel;
                LAS unsigned* lcnt = (LAS unsigned*)(lds + LDS_TAB + 1024); LAS unsigned* lbase = lcnt + 32;
                if (tid < 32) lcnt[tid] = 0u;
                f32x4 a0 = (f32x4){0.f, 0.f, 0.f, 0.f}, a1 = (f32x4){0.f, 0.f, 0.f, 0.f};
                const float* xr = X2 + (size_t)(t0 + fr) * DM + 512 * kh + 4 * fq;
                const float* wr0 = w_router + (size_t)(512 * kh + 4 * fq) * NE + fr;
#pragma unroll 4
                for (int kb = 0; kb < 32; ++kb) {
                    const f32x4 xa = *(const f32x4*)(xr + 16 * kb);
                    const float* wrp = wr0 + (size_t)(16 * kb) * NE;
                    float wv0[4], wv1[4];
#pragma unroll
                    for (int c = 0; c < 4; ++c) { wv0[c] = wrp[c * NE]; wv1[c] = wrp[c * NE + 16]; }
#pragma unroll
                    for (int c = 0; c < 4; ++c) { a0 = __builtin_amdgcn_mfma_f32_16x16x4f32(xa[c], wv0[c], a0, 0, 0, 0); a1 = __builtin_amdgcn_mfma_f32_16x16x4f32(xa[c], wv1[c], a1, 0, 0, 0); }
                }
                LAS f32x4* px = (LAS f32x4*)lds;
                if (kh == 1) { px[(tg * 64 + lane) * 2] = a0; px[(tg * 64 + lane) * 2 + 1] = a1; }
                WG_BARRIER();
                float mye[4]; int myi[4]; unsigned lpos[4];
                if (kh == 0) {
                    a0 = a0 + px[(tg * 64 + lane) * 2]; a1 = a1 + px[(tg * 64 + lane) * 2 + 1];
                    const float br0 = b_router[fr], br1 = b_router[16 + fr];
#pragma unroll
                    for (int r = 0; r < 4; ++r) { float v0 = a0[r] + br0, v1 = a1[r] + br1; float sv[4]; int si[4];
#pragma unroll
                        for (int kq = 0; kq < 4; ++kq) { float bv = (v0 >= v1) ? v0 : v1; int bi = (v0 >= v1) ? fr : 16 + fr;
#pragma unroll
                            for (int o = 1; o < 16; o <<= 1) { const float ov = __shfl_xor(bv, o); const int oi = __shfl_xor(bi, o); const bool take = (ov > bv) || (ov == bv && oi < bi); bv = take ? ov : bv; bi = take ? oi : bi; }
                            sv[kq] = bv; si[kq] = bi; if (bi == fr) v0 = -3.0e38f; if (bi == 16 + fr) v1 = -3.0e38f; }
                        const float e1 = fast_exp2(1.4426950408889634f * (sv[1] - sv[0])), e2 = fast_exp2(1.4426950408889634f * (sv[2] - sv[0])), e3 = fast_exp2(1.4426950408889634f * (sv[3] - sv[0]));
                        const float inv = 1.0f / (((1.0f + e1) + e2) + e3);
                        mye[r] = ((fr == 0) ? 1.0f : (fr == 1) ? e1 : (fr == 2) ? e2 : e3) * inv;
                        myi[r] = (fr == 0) ? si[0] : (fr == 1) ? si[1] : (fr == 2) ? si[2] : si[3];
                        lpos[r] = 0u;
                        if (fr < 4) lpos[r] = atomicAdd((unsigned*)(lcnt + myi[r]), 1u);
                    }
                }
                WG_BARRIER();
                if (tid < 32) lbase[tid] = atomicAdd(cntp + tid, lcnt[tid]);
                WG_BARRIER();
                if (kh == 0 && fr < 4) {
#pragma unroll
                    for (int r = 0; r < 4; ++r) { const int tok = t0 + 4 * fq + r; const unsigned pos = lbase[myi[r]] + lpos[r];
                        ltok[(size_t)myi[r] * NTOK + pos] = tok; lgate[(size_t)myi[r] * NTOK + pos] = mye[r]; selp[tok * 4 + fr] = myi[r] * NTOK + (int)pos; }
                }
            }
            WG_BARRIER();
        }
        GRID_BAR();
        LAS int* tab = (LAS int*)(lds + LDS_TAB);
        if (threadIdx.x == 0) { int rb = 0, tp = 0;
            for (int e = 0; e < NE; ++e) { const int c = (int)xb_ld(cnt + e); const int nt = (c + 255) >> 8; tab[e] = c; tab[32 + e] = nt; tab[64 + e] = rb; tab[96 + e] = tp; rb += nt * 256; tp += nt; }
            tab[96 + NE] = tp; }
        WG_BARRIER();
        const int ntile_tot = tab[96 + NE];
        if (PH(9)) REP(9)
#pragma unroll 1
        for (int u = vcu; u < ntile_tot * 8; u += G) {
            int e = 0;
#pragma unroll 1
            for (int q = 1; q < NE; ++q) if (u >= tab[96 + q] * 8) e = q;
            const int v = u - tab[96 + e] * 8, nt = tab[32 + e], ct = v / nt, rt = v - ct * nt;
            RowList rm{list_tok + (size_t)e * NTOK + 256 * rt, tab[e] - 256 * rt};
            EpiSwiglu E{ABUF, b_gu + (size_t)e * 2 * DM, tab[64 + e] + 256 * rt, 128 * ct};
            if (rep_ == 0) gemm_tile<0>(lds, X2B, DM, rm, w_gu + (size_t)e * DM * 2 * DM, 2 * DM, 128 * ct, DM + 128 * ct, E, rt);
            else gemm_tile<PROBE_MODE>(lds, X2B, DM, rm, w_gu + (size_t)e * DM * 2 * DM, 2 * DM, 128 * ct, DM + 128 * ct, E, rt);
        }
        GRID_BAR();
        if (PH(10)) REP(10)
#pragma unroll 1
        for (int u = vcu; u < ntile_tot * 4; u += G) {
            int e = 0;
#pragma unroll 1
            for (int q = 1; q < NE; ++q) if (u >= tab[96 + q] * 4) e = q;
            const int v = u - tab[96 + e] * 4, nt = tab[32 + e], ct = v / nt, rt = v - ct * nt;
            RowLinear rm{tab[64 + e] + 256 * rt};
            EpiDown E{YBUF, b_down + (size_t)e * DM, list_gate + (size_t)e * NTOK + 256 * rt, tab[64 + e] + 256 * rt, 256 * ct};
            gemm_tile(lds, ABUF, DM, rm, w_down + (size_t)e * DM * DM, DM, 256 * ct, 256 * ct + 128, E, rt);
        }
        GRID_BAR();
        if (PH(11)) REP(11)
#pragma unroll 1
        for (int row = vcu * 8 + (int)(threadIdx.x >> 6); row < NTOK; row += G * 8) {
            PHASE_IDS();
            int rows[4];
#pragma unroll
            for (int k = 0; k < 4; ++k) { const int s = sel[row * 4 + k]; const int e = s >> 14, pos = s & (NTOK - 1); rows[k] = tab[64 + e] + pos; }
            f32x4 v[4]; float sm = 0.f;
#pragma unroll
            for (int j = 0; j < 4; ++j) { v[j] = *(const f32x4*)(X2 + (size_t)row * DM + 256 * j + 4 * lane) * ALPHA;
#pragma unroll
                for (int k = 0; k < 4; ++k) { const u32x2 y = *(const u32x2*)(YBUF + (size_t)rows[k] * DM + 256 * j + 4 * lane);
                    v[j][0] += bf2f(y.x & 0xffffu); v[j][1] += bf2f(y.x >> 16); v[j][2] += bf2f(y.y & 0xffffu); v[j][3] += bf2f(y.y >> 16); }
                sm += (v[j][0] + v[j][1]) + (v[j][2] + v[j][3]); }
            const float mean = wave_sum(sm) * (1.0f / DM); float q = 0.f;
#pragma unroll
            for (int j = 0; j < 4; ++j) { v[j] = v[j] - mean; q += (v[j][0] * v[j][0] + v[j][1] * v[j][1]) + (v[j][2] * v[j][2] + v[j][3] * v[j][3]); }
            const float rstd = 1.0f / sqrtf(wave_sum(q) * (1.0f / DM) + LN_EPS);
#pragma unroll
            for (int j = 0; j < 4; ++j) { const f32x4 gg = *(const f32x4*)(ln_g + 2 * DM + 256 * j + 4 * lane), bb = *(const f32x4*)(ln_b + 2 * DM + 256 * j + 4 * lane);
                const f32x4 o = v[j] * rstd * gg + bb; *(f32x4*)(xout + (size_t)row * DM + 256 * j + 4 * lane) = o;
                u32x2 w; w.x = pk_bf16(o[0], o[1]); w.y = pk_bf16(o[2], o[3]); *(u32x2*)(XB + (size_t)row * DM + 256 * j + 4 * lane) = w; }
        }
        if (l + 1 < DEPTH) GRID_BAR();
    }
}

extern "C" void kernel_launch(void* const* d_in, const int* in_sizes, int n_in, void* d_out, int out_size, void* d_ws, size_t ws_size, hipStream_t stream) {
    static int grid = 0;
    if (grid == 0) {
        if (n_in != 20 || out_size != NTOK * DM || ws_size < WS_END) { fprintf(stderr, "kernel_launch: unexpected shapes (n_in %d, out %d, ws %zu)\n", n_in, out_size, ws_size); grid = -1; return; }
        int dev = 0, cus = 0;
        if (hipGetDevice(&dev) != hipSuccess || hipDeviceGetAttribute(&cus, hipDeviceAttributeMultiprocessorCount, dev) != hipSuccess) { grid = -1; return; }
        if (hipFuncSetAttribute((const void*)mega_fwd, hipFuncAttributeMaxDynamicSharedMemorySize, LDS_BYTES) != hipSuccess) { fprintf(stderr, "kernel_launch: hipFuncSetAttribute failed\n"); grid = -1; return; }
        (void)hipGetLastError();
        grid = cus;
    }
    if (grid < 0) return;
    (void)hipMemsetAsync((char*)d_ws + WS_CTL, 0, CTL_BYTES, stream);
    Params p{};
    for (int i = 0; i < 20; ++i) p.in[i] = (const float*)d_in[i];
    p.out = (float*)d_out; p.ws = (unsigned char*)d_ws;
    hipLaunchKernelGGL(mega_fwd, dim3(grid), dim3(512), LDS_BYTES, stream, p);
}
```
